# Optimizing an MI355X kernel written in HIP

```python
import math
import jax, jax.numpy as jnp
from jax import lax
import numpy as np

D_MODEL = 1024
BATCH = 16
SEQ = 256
DEPTH = 2
DEC_BATCH = 4
DEC_SEQ = 1024
PAST_LEN = 256

GRID_W = 64
HEAD_DIM = 64
DA_HEADS = 4
DA_QK = 2 * HEAD_DIM
DA_V = 2 * HEAD_DIM
WG_Q_HEADS = 8
WG_KV_HEADS = 2
WINDOW = 128
RT_HEADS = 4
RT_DK = HEAD_DIM
RT_DV = 2 * HEAD_DIM
RT_CHUNK = 128
BRANCH_W = 512
SPLITS = (DA_HEADS * DA_QK, DA_HEADS * DA_QK, DA_HEADS * DA_V,
          WG_Q_HEADS * HEAD_DIM, WG_KV_HEADS * HEAD_DIM, WG_KV_HEADS * HEAD_DIM,
          RT_HEADS * RT_DK, RT_HEADS * RT_DK, RT_HEADS * RT_DV, RT_HEADS * RT_DV)
D_IN = sum(SPLITS)
D_FF = 4 * D_MODEL
Q_BLOCK = 128
ROPE_BASE = 10000.0
LN_EPS = 1e-5
NEG_INF = -1e30
ALPHA = (2 * DEPTH) ** 0.25
BETA = (8 * DEPTH) ** -0.25

kernel_name = "hybrid_diffattn_swa_retention_dit_step"

F32 = jnp.float32


def layer_norm(x, g, b):
    xf = x.astype(F32)
    mu = jnp.mean(xf, axis=-1, keepdims=True)
    var = jnp.mean(jnp.square(xf - mu), axis=-1, keepdims=True)
    y = (xf - mu) * lax.rsqrt(var + LN_EPS)
    return (y * g.astype(F32) + b.astype(F32)).astype(x.dtype)


def head_rms_norm(x, g):
    xf = x.astype(F32)
    y = xf * lax.rsqrt(jnp.mean(jnp.square(xf), axis=-1, keepdims=True) + LN_EPS)
    return (y * g.astype(F32)).astype(x.dtype)


def head_layer_norm(x, g):
    xf = x.astype(F32)
    mu = jnp.mean(xf, axis=-1, keepdims=True)
    var = jnp.mean(jnp.square(xf - mu), axis=-1, keepdims=True)
    return ((xf - mu) * lax.rsqrt(var + LN_EPS) * g.astype(F32)).astype(x.dtype)


def axial_rope_angles(rows, dim):
    r, col = jnp.meshgrid(jnp.arange(rows), jnp.arange(GRID_W), indexing="ij")
    r = r.reshape(-1).astype(F32)
    col = col.reshape(-1).astype(F32)
    nf = dim // 4
    inv = ROPE_BASE ** (-jnp.arange(nf, dtype=F32) / nf)
    return r[:, None] * inv[None, :], col[:, None] * inv[None, :]


def apply_axial_rope(x, ang):
    ang_r, ang_c = ang

    def rot(u, a):
        cos = jnp.cos(a)[None, :, None, :]
        sin = jnp.sin(a)[None, :, None, :]
        u1, u2 = jnp.split(u.astype(F32), 2, axis=-1)
        return jnp.concatenate([u1 * cos - u2 * sin, u1 * sin + u2 * cos], axis=-1)

    xr, xc = jnp.split(x, 2, axis=-1)
    return jnp.concatenate([rot(xr, ang_r), rot(xc, ang_c)], axis=-1).astype(x.dtype)


def rope_subheads(x, ang):
    b, t, h, _ = x.shape
    return apply_axial_rope(x.reshape(b, t, h * 2, HEAD_DIM), ang).reshape(b, t, h, 2 * HEAD_DIM)


def to_blocks(t, size):
    b, n = t.shape[:2]
    return jnp.moveaxis(t.reshape(b, n // size, size, *t.shape[2:]), 1, 0)


def from_blocks(o):
    o = jnp.moveaxis(o, 0, 1)
    return o.reshape(o.shape[0], o.shape[1] * o.shape[2], *o.shape[3:])


def diff_attention(q, k, v, lam):
    scale = HEAD_DIM ** -0.5
    k1, k2 = k[..., :HEAD_DIM], k[..., HEAD_DIM:]

    def block(qb):
        q1, q2 = qb[..., :HEAD_DIM], qb[..., HEAD_DIM:]
        s1 = jnp.einsum("bqhd,bkhd->bhqk", q1, k1).astype(F32) * scale
        s2 = jnp.einsum("bqhd,bkhd->bhqk", q2, k2).astype(F32) * scale
        a = jax.nn.softmax(s1, axis=-1) - lam * jax.nn.softmax(s2, axis=-1)
        return jnp.einsum("bhqk,bkhe->bqhe", a.astype(v.dtype), v)

    return from_blocks(lax.map(block, to_blocks(q, Q_BLOCK)))


def sink_logits(sink, shape):
    hkv, g = shape[1], shape[2]
    return jnp.broadcast_to(sink.astype(F32).reshape(hkv, g)[None, :, :, None, None], shape[:-1] + (1,))


def dense_sink_attention(q, k, v, sink):
    b, t, hq, d = q.shape
    hkv = k.shape[2]
    q = q.reshape(b, t, hkv, hq // hkv, d)
    scale = d ** -0.5

    def block(qb):
        s = jnp.einsum("bqhgd,bkhd->bhgqk", qb, k).astype(F32) * scale
        p = jax.nn.softmax(jnp.concatenate([s, sink_logits(sink, s.shape)], axis=-1), axis=-1)[..., :-1]
        return jnp.einsum("bhgqk,bkhd->bqhgd", p.astype(v.dtype), v)

    return from_blocks(lax.map(block, to_blocks(q, Q_BLOCK))).reshape(b, t, hq * d)


def window_sink_attention(q, k, v, k_ctx, v_ctx, sink):
    b, t, hq, d = q.shape
    hkv = k.shape[2]
    nb = t // WINDOW
    q = q.reshape(b, t, hkv, hq // hkv, d)
    scale = d ** -0.5
    pad = ((0, 0), (WINDOW, WINDOW), (0, 0), (0, 0))
    kp = jnp.pad(k, pad)
    vp = jnp.pad(v, pad)
    qi = jnp.arange(WINDOW)[:, None]
    kj = jnp.arange(3 * WINDOW)[None, :]
    rel = kj - WINDOW - qi

    def block(args):
        n, qb = args
        kb = lax.dynamic_slice_in_dim(kp, n * WINDOW, 3 * WINDOW, axis=1)
        vb = lax.dynamic_slice_in_dim(vp, n * WINDOW, 3 * WINDOW, axis=1)
        kpos = n * WINDOW - WINDOW + kj
        valid = (jnp.abs(rel) <= WINDOW) & (kpos >= 0) & (kpos < t)
        s_loc = jnp.einsum("bqhgd,bkhd->bhgqk", qb, kb).astype(F32) * scale
        s_loc = jnp.where(valid, s_loc, NEG_INF)
        s_ctx = jnp.einsum("bqhgd,bchd->bhgqc", qb, k_ctx).astype(F32) * scale
        p = jax.nn.softmax(jnp.concatenate([s_loc, s_ctx, sink_logits(sink, s_loc.shape)], axis=-1), axis=-1)
        p_loc = p[..., :3 * WINDOW].astype(v.dtype)
        p_ctx = p[..., 3 * WINDOW:-1].astype(v.dtype)
        return (jnp.einsum("bhgqk,bkhd->bqhgd", p_loc, vb)
                + jnp.einsum("bhgqc,bchd->bqhgd", p_ctx, v_ctx))

    o = lax.map(block, (jnp.arange(nb), to_blocks(q, WINDOW)))
    return from_blocks(o).reshape(b, t, hq * d)


def retention_direction(q, k, v, log_g, s0):
    c = RT_CHUNK
    pos = jnp.arange(c, dtype=F32)
    diff = pos[:, None] - pos[None, :]
    decay_in = jnp.where(diff[None] >= 0,
                         jnp.exp(jnp.maximum(diff, 0.0)[None] * log_g[:, None, None]), 0.0)
    xi = jnp.exp((pos + 1.0)[None, :] * log_g[:, None]).T[None, :, :, None]
    zeta = jnp.exp((c - 1.0 - pos)[None, :] * log_g[:, None])
    g_chunk = jnp.exp(c * log_g)[None, :, None, None]

    def chunk(s, inp):
        qc, kc, vc = inp
        a = jnp.einsum("bqhd,bkhd->bhqk", qc, kc) * decay_in
        inner = jnp.einsum("bhqk,bkhe->bqhe", a, vc)
        cross = jnp.einsum("bqhd,bhde->bqhe", qc, s) * xi
        s_new = g_chunk * s + jnp.einsum("bkhd,bkhe,hk->bhde", kc, vc, zeta)
        return s_new, inner + cross

    s_fin, out = lax.scan(chunk, s0, (to_blocks(q, c), to_blocks(k, c), to_blocks(v, c)))
    return from_blocks(out), s_fin


def bidirectional_retention(q, k, v, log_g2, s0):
    q, k, v = q.astype(F32), k.astype(F32), v.astype(F32)
    s0 = s0.astype(F32)
    y_f, s_f = retention_direction(q, k, v, log_g2[0], s0[:, 0])
    flip = lambda a: jnp.flip(a, axis=1)
    y_b, s_b = retention_direction(flip(q), flip(k), flip(v), log_g2[1], s0[:, 1])
    return y_f + flip(y_b), jnp.stack([s_f, s_b], axis=1)


def token_mixer(h, P, lam_init, ctx, rope_ang):
    b, t, _ = h.shape
    z = h @ P["w_in"]
    parts = []
    off = 0
    for s in SPLITS:
        parts.append(z[..., off:off + s])
        off += s
    aq, ak, av, bq, bk, bv, cq, ck, cv, cg = parts
    aq = aq.reshape(b, t, DA_HEADS, DA_QK)
    ak = ak.reshape(b, t, DA_HEADS, DA_QK)
    av = av.reshape(b, t, DA_HEADS, DA_V)
    bq = bq.reshape(b, t, WG_Q_HEADS, HEAD_DIM)
    bk = bk.reshape(b, t, WG_KV_HEADS, HEAD_DIM)
    bv = bv.reshape(b, t, WG_KV_HEADS, HEAD_DIM)
    cq = cq.reshape(b, t, RT_HEADS, RT_DK)
    ck = ck.reshape(b, t, RT_HEADS, RT_DK) * (RT_DK ** -0.5)
    cv = cv.reshape(b, t, RT_HEADS, RT_DV)
    if rope_ang is not None:
        aq = rope_subheads(aq, rope_ang)
        ak = rope_subheads(ak, rope_ang)
        bq = apply_axial_rope(bq, rope_ang)
        bk = apply_axial_rope(bk, rope_ang)
    lv = P["diff_lam"].astype(F32)
    lam = jnp.exp(jnp.sum(lv[0] * lv[1])) - jnp.exp(jnp.sum(lv[2] * lv[3])) + lam_init
    if ctx is None:
        oa = diff_attention(aq, ak, av, lam)
        ob = dense_sink_attention(bq, bk, bv, P["win_sink"])
        s0 = jnp.zeros((b, 2, RT_HEADS, RT_DK, RT_DV), F32)
    else:
        ctx_ak, ctx_av, ctx_bk, ctx_bv, s0 = ctx
        oa = diff_attention(aq, jnp.concatenate([ak, ctx_ak], axis=1),
                            jnp.concatenate([av, ctx_av], axis=1), lam)
        ob = window_sink_attention(bq, bk, bv, ctx_bk, ctx_bv, P["win_sink"])
    oa = (head_rms_norm(oa, P["diff_norm_g"]) * (1.0 - lam_init)).reshape(b, t, BRANCH_W)
    log_g2 = jax.nn.log_sigmoid(P["ret_decay"].astype(F32))
    yc, s_fin = bidirectional_retention(cq, ck, cv, log_g2, s0)
    oc = head_layer_norm(yc, P["ret_norm_g"]).astype(h.dtype).reshape(b, t, BRANCH_W) * jax.nn.silu(cg)
    gates = jax.nn.sigmoid(h @ P["w_gate"] + P["b_gate"])
    ga, gb, gc = jnp.split(gates, 3, axis=-1)
    merged = ga * (oa @ P["w_pa"]) + gb * (ob @ P["w_pb"]) + gc * (oc @ P["w_pc"])
    out = merged @ P["w_o"]
    new_ctx = (ak, av, bk, bv, s_fin.astype(h.dtype)) if ctx is None else None
    return out, new_ctx


def trunk_layer(x, mod, P, lam_init, ctx, rope_ang):
    sh1, sc1, g1, sh2, sc2, g2 = jnp.split(mod, 6, axis=-1)
    h = x * (1.0 + sc1) + sh1
    y, new_ctx = token_mixer(h, P, lam_init, ctx, rope_ang)
    x = layer_norm(ALPHA * x + g1 * y, P["ln1_g"], P["ln1_b"])
    h = x * (1.0 + sc2) + sh2
    f = jnp.square(jax.nn.relu(h @ P["w_ff1"])) @ P["w_ff2"]
    x = layer_norm(ALPHA * x + g2 * f, P["ln2_g"], P["ln2_b"])
    return x, new_ctx


def setup_inputs(seed: int = 0) -> dict:
    key = jax.random.key(seed)
    ks = jax.random.split(key, 40)
    nrm = lambda k, shape, s: jax.random.normal(k, shape, F32) * s
    D = D_MODEL
    p = 2.0 ** (-(5.0 + jnp.arange(RT_HEADS, dtype=F32)))
    base_logit = jnp.log1p(-p) - jnp.log(p)
    return {
        "x_prompt": nrm(ks[0], (BATCH, SEQ, D), 1.0),
        "x_sample": nrm(ks[1], (DEC_BATCH, DEC_SEQ, D), 1.0),
        "c": nrm(ks[2], (DEC_BATCH, D), 1.0),
        "cache_diff_k": nrm(ks[3], (DEC_BATCH, DEPTH, PAST_LEN, DA_HEADS, DA_QK), 1.0),
        "cache_diff_v": nrm(ks[4], (DEC_BATCH, DEPTH, PAST_LEN, DA_HEADS, DA_V), 1.0),
        "cache_win_k": nrm(ks[5], (DEC_BATCH, DEPTH, PAST_LEN, WG_KV_HEADS, HEAD_DIM), 1.0),
        "cache_win_v": nrm(ks[6], (DEC_BATCH, DEPTH, PAST_LEN, WG_KV_HEADS, HEAD_DIM), 1.0),
        "state_ret": nrm(ks[7], (DEC_BATCH, DEPTH, 2, RT_HEADS, RT_DK, RT_DV), 1.0),
        "c_ctx": nrm(ks[8], (D,), 1.0),
        "w_mod": nrm(ks[9], (DEPTH, D, 6 * D), D ** -0.5),
        "b_mod": nrm(ks[10], (DEPTH, 6 * D), 0.02),
        "w_in": nrm(ks[11], (DEPTH, D, D_IN), D ** -0.5),
        "diff_lam": nrm(ks[12], (DEPTH, 4, HEAD_DIM), 0.1),
        "diff_norm_g": 1.0 + nrm(ks[13], (DEPTH, DA_V), 0.02),
        "win_sink": nrm(ks[14], (DEPTH, WG_Q_HEADS), 0.5),
        "ret_decay": base_logit[None, None, :] + nrm(ks[15], (DEPTH, 2, RT_HEADS), 0.05),
        "ret_norm_g": 1.0 + nrm(ks[16], (DEPTH, RT_DV), 0.02),
        "w_pa": nrm(ks[17], (DEPTH, BRANCH_W, D), BRANCH_W ** -0.5),
        "w_pb": nrm(ks[18], (DEPTH, BRANCH_W, D), BRANCH_W ** -0.5),
        "w_pc": nrm(ks[19], (DEPTH, BRANCH_W, D), BRANCH_W ** -0.5),
        "w_gate": nrm(ks[20], (DEPTH, D, 3 * D), D ** -0.5),
        "b_gate": nrm(ks[21], (DEPTH, 3 * D), 0.02),
        "w_o": nrm(ks[22], (DEPTH, D, D), BETA * D ** -0.5),
        "ln1_g": 1.0 + nrm(ks[23], (DEPTH, D), 0.02),
        "ln1_b": nrm(ks[24], (DEPTH, D), 0.02),
        "w_ff1": nrm(ks[25], (DEPTH, D, D_FF), D ** -0.5),
        "w_ff2": nrm(ks[26], (DEPTH, D_FF, D), BETA * D_FF ** -0.5),
        "ln2_g": 1.0 + nrm(ks[27], (DEPTH, D), 0.02),
        "ln2_b": nrm(ks[28], (DEPTH, D), 0.02),
    }


def reference(x_prompt, x_sample, c, cache_diff_k, cache_diff_v, cache_win_k, cache_win_v, state_ret,
              c_ctx, w_mod, b_mod, w_in, diff_lam, diff_norm_g, win_sink, ret_decay, ret_norm_g,
              w_pa, w_pb, w_pc, w_gate, b_gate, w_o, ln1_g, ln1_b, w_ff1, w_ff2, ln2_g, ln2_b):
    rows = x_sample.shape[1] // GRID_W
    rope_ang = axial_rope_angles(rows, HEAD_DIM)
    xp = x_prompt
    xs = x_sample
    diff_k, diff_v, win_k, win_v, ret_s = [], [], [], [], []
    for l in range(DEPTH):
        P = {
            "w_in": w_in[l], "diff_lam": diff_lam[l], "diff_norm_g": diff_norm_g[l],
            "win_sink": win_sink[l], "ret_decay": ret_decay[l], "ret_norm_g": ret_norm_g[l],
            "w_pa": w_pa[l], "w_pb": w_pb[l], "w_pc": w_pc[l], "w_gate": w_gate[l],
            "b_gate": b_gate[l], "w_o": w_o[l], "ln1_g": ln1_g[l], "ln1_b": ln1_b[l],
            "w_ff1": w_ff1[l], "w_ff2": w_ff2[l], "ln2_g": ln2_g[l], "ln2_b": ln2_b[l],
        }
        lam_init = 0.8 - 0.6 * math.exp(-0.3 * l)
        mod_ctx = (jax.nn.silu(c_ctx) @ w_mod[l] + b_mod[l])[None, None, :]
        xp, ctx_l = trunk_layer(xp, mod_ctx, P, lam_init, None, None)
        diff_k.append(ctx_l[0])
        diff_v.append(ctx_l[1])
        win_k.append(ctx_l[2])
        win_v.append(ctx_l[3])
        ret_s.append(ctx_l[4])
        mod_lat = (jax.nn.silu(c) @ w_mod[l] + b_mod[l])[:, None, :]
        cache_l = (cache_diff_k[:, l], cache_diff_v[:, l], cache_win_k[:, l], cache_win_v[:, l], state_ret[:, l])
        xs, _ = trunk_layer(xs, mod_lat, P, lam_init, cache_l, rope_ang)
    new_diff_k = jnp.stack(diff_k, axis=1)
    new_diff_v = jnp.stack(diff_v, axis=1)
    new_win_k = jnp.stack(win_k, axis=1)
    new_win_v = jnp.stack(win_v, axis=1)
    new_state_ret = jnp.stack(ret_s, axis=1)
    return (xp, xs, new_diff_k, new_diff_v, new_win_k, new_win_v, new_state_ret)
```

```cpp
#include <hip/hip_runtime.h>
#include <hip/hip_cooperative_groups.h>
#include <cstdio>
#include <cstdint>
#include <cmath>
namespace cg = cooperative_groups;

typedef unsigned short bf16_t;
typedef short bf16x8 __attribute__((ext_vector_type(8)));
typedef float f32x4 __attribute__((ext_vector_type(4)));
typedef unsigned u32x4 __attribute__((ext_vector_type(4)));
typedef unsigned u32x2 __attribute__((ext_vector_type(2)));
typedef short s16x4 __attribute__((ext_vector_type(4)));
typedef __bf16 bf16x2_t __attribute__((ext_vector_type(2)));
typedef float f32x2_t __attribute__((ext_vector_type(2)));
typedef __attribute__((address_space(3))) s16x4* lds_s16x4_ptr;
#define LAS __attribute__((address_space(3)))

#define LOG2E 1.4426950408889634f
#define ALPHA_RES 1.4142135623730951f
#define LN_EPS 1e-5f

constexpr size_t SZ_WCAT = 6912ull * 1024 * 2, SZ_WP = 3ull * 1024 * 512 * 2, SZ_WO = 1024ull * 1024 * 2, SZ_WF = 4096ull * 1024 * 2;
constexpr size_t OFF_WCAT = 0;
constexpr size_t OFF_WP = OFF_WCAT + 2 * SZ_WCAT;
constexpr size_t OFF_WO = OFF_WP + 2 * SZ_WP;
constexpr size_t OFF_WF1 = OFF_WO + 2 * SZ_WO;
constexpr size_t OFF_WF2 = OFF_WF1 + 2 * SZ_WF;
constexpr size_t OFF_CDK = OFF_WF2 + 2 * SZ_WF;
constexpr size_t OFF_CDV = OFF_CDK + 2097152;
constexpr size_t OFF_CWK = OFF_CDV + 2097152;
constexpr size_t OFF_CWV = OFF_CWK + 524288;
constexpr size_t OFF_MOD = OFF_CWV + 524288;
constexpr size_t OFF_ROPE = OFF_MOD + 245760;
constexpr size_t OFF_H = OFF_ROPE + 8192;
constexpr size_t OFF_OA = OFF_H + 16777216;
constexpr size_t OFF_OB = OFF_OA + 8388608;
constexpr size_t OFF_OC = OFF_OB + 8388608;
constexpr size_t OFF_MRG = OFF_OC + 8388608;
constexpr size_t OFF_R = OFF_MRG + 16777216;
constexpr size_t OFF_Z = OFF_R;
constexpr size_t OFF_G = OFF_Z + 8192ull * 3840 * 2;
constexpr size_t OFF_HID = OFF_R;
constexpr size_t OFF_Y = OFF_R + 8192ull * 4096 * 2;
constexpr size_t OFF_CNT = OFF_G + 8192ull * 3072 * 2;
constexpr size_t OFF_BAR = OFF_CNT + 16384;
constexpr size_t OFF_YB = OFF_BAR + 3456 * 4 + 256;
constexpr size_t WS_NEED = OFF_YB + 8192ull * 512 * 4;
constexpr int NTHR = 512;
constexpr int LDS_BYTES = 131072 + 64;
constexpr int LDS_ST = 131072 + 16;
constexpr int LDS_FLAG = 131072;

constexpr size_t OUT_X = 0, OUT_DK = 8388608, OUT_DV = 12582912, OUT_WK = 16777216, OUT_WV = 17825792, OUT_ST = 18874368;

struct Params {
  const float *x_prompt, *x_sample, *c, *cache_diff_k, *cache_diff_v, *cache_win_k, *cache_win_v, *state_ret, *c_ctx;
  const float *w_mod, *b_mod, *w_in, *diff_lam, *diff_norm_g, *win_sink, *ret_decay, *ret_norm_g;
  const float *w_pa, *w_pb, *w_pc, *w_gate, *b_gate, *w_o, *ln1_g, *ln1_b, *w_ff1, *w_ff2, *ln2_g, *ln2_b;
  float* out;
  char* ws;
  float lam_init[2];
};

__device__ __forceinline__ unsigned cvtpk(float lo, float hi) { f32x2_t v = {lo, hi}; bf16x2_t b = __builtin_convertvector(v, bf16x2_t); return __builtin_bit_cast(unsigned, b); }
__device__ __forceinline__ bf16_t f2bf(float f) { return (bf16_t)(cvtpk(f, 0.f) & 0xffffu); }
__device__ __forceinline__ float bf2f(unsigned short b) { return __uint_as_float(((unsigned)b) << 16); }
__device__ __forceinline__ float bflo(unsigned u) { return __uint_as_float(u << 16); }
__device__ __forceinline__ float bfhi(unsigned u) { return __uint_as_float(u & 0xffff0000u); }
__device__ __forceinline__ u32x2 pack4(f32x4 v) { u32x2 r; r.x = cvtpk(v[0], v[1]); r.y = cvtpk(v[2], v[3]); return r; }
__device__ __forceinline__ f32x4 unpack4(u32x2 u) { f32x4 r; r[0] = bflo(u.x); r[1] = bfhi(u.x); r[2] = bflo(u.y); r[3] = bfhi(u.y); return r; }
__device__ __forceinline__ s16x4 vtr(const char* p) { return __builtin_amdgcn_ds_read_tr16_b64_v4i16((lds_s16x4_ptr)(p)); }
__device__ __forceinline__ bf16x8 cat8(s16x4 lo, s16x4 hi) { return (bf16x8){lo[0], lo[1], lo[2], lo[3], hi[0], hi[1], hi[2], hi[3]}; }
__device__ __forceinline__ f32x4 mfma16(bf16x8 a, bf16x8 b, f32x4 c) { return __builtin_amdgcn_mfma_f32_16x16x32_bf16(a, b, c, 0, 0, 0); }
__device__ __forceinline__ float quad_sum(float v) { v += __shfl_xor(v, 16); v += __shfl_xor(v, 32); return v; }
__device__ __forceinline__ float quad_max(float v) { v = fmaxf(v, __shfl_xor(v, 16)); v = fmaxf(v, __shfl_xor(v, 32)); return v; }
__device__ __forceinline__ float wave_sum(float v) {
#pragma unroll
  for (int o = 32; o > 0; o >>= 1) v += __shfl_xor(v, o);
  return v;
}
__device__ __forceinline__ int lane_id() { return (int)__builtin_amdgcn_mbcnt_hi(~0u, __builtin_amdgcn_mbcnt_lo(~0u, 0u)); }
__device__ __forceinline__ int ozero() { int z; asm volatile("s_mov_b32 %0, 0" : "=s"(z)); return z; }
__device__ __forceinline__ int otid_w(int wbase) { asm volatile("" : "+s"(wbase)); return wbase | lane_id(); }
#define otid() otid_w(wb)
__device__ __forceinline__ char* opq(char* w) { return (char*)((uintptr_t)w ^ (uintptr_t)(unsigned)ozero()); }
__device__ __forceinline__ float* opqf(float* w) { return (float*)((uintptr_t)w ^ (uintptr_t)(unsigned)ozero()); }
__device__ __forceinline__ int row_group(int row) { return row < 4096 ? 0 : 1 + ((row - 4096) >> 10); }

#define WS(p) opq((p).ws)
#define OUTP(p) opqf((p).out)

namespace pg8 {
#define PG8_LAS __attribute__((address_space(3)))
constexpr int BM = 256, BK = 64, HALF = 128, HTB = HALF * BK * 2  , STAGE_BYTES = 8 * HTB, NXCD = 8, WGM = 8;

__host__ __device__ __forceinline__ int lds_byte(int r, int c) { const int st = (r >> 4) * 2 + (c >> 5), rr = r & 15, cc = c & 31, ob = rr * 64 + cc * 2; return st * 1024 + (ob ^ (((ob >> 9) & 1) << 5)); }
__host__ __device__ __forceinline__ void stage_rc(int b, int& R, int& C) { const int st = b / 1024, sb = b % 1024, swz = sb ^ (((sb >> 9) & 1) << 5); R = (st >> 1) * 16 + swz / 64; C = (st & 1) * 32 + (swz % 64) / 2; }
__host__ __device__ __forceinline__ int perm32(int rho) { const int n = rho >> 4, i = rho & 15; return 8 * (i >> 2) + 4 * n + (i & 3); }

struct Unit { int pm, pn, ko, sn, slot; };
struct Gemm { const bf16_t* A; const bf16_t* Bt; int ld, K; };

struct StaticOrder {
    int nM, nN, nwg, G, c, kt;
    __host__ __device__ __forceinline__ void init(int M, int N, int G_, int c_, int kt_) { nM = M / BM; nN = N / BM; nwg = nM * nN; G = G_; c = c_; kt = kt_; }
    __host__ __device__ __forceinline__ bool next(int i, Unit& u) const { return at((long)i * G + c, u); }
    __host__ __device__ __forceinline__ bool at(long L, Unit& u) const {
        if (L >= nwg) return false;
        int wgid = (int)L; { const int q = nwg / NXCD, r = nwg % NXCD, xcd = wgid % NXCD, off = wgid / NXCD; wgid = (xcd < r ? xcd * (q + 1) : r * (q + 1) + (xcd - r) * q) + off; }
        const int nig = WGM * nN, gid = wgid / nig, fm = gid * WGM, gsz = (nM - fm) < WGM ? (nM - fm) : WGM;
        u.pm = fm + ((wgid % nig) % gsz); u.pn = (wgid % nig) / gsz; u.ko = 0; u.sn = 1; u.slot = 0; return true;
    }
    __device__ __forceinline__ void a_ready(const Unit&) const {}
    __device__ __forceinline__ void done(const Unit&) const {}
};


template <class Epi, class Sched, bool ALIGN_EPI = false, bool SP2 = false>
__device__ __forceinline__ void gemm_phase(PG8_LAS unsigned char* lds, const Gemm g, const Sched& S, const Epi& E, int wbase) {
    const int tid = otid_w(wbase), wid = __builtin_amdgcn_readfirstlane(tid >> 6), lane = tid & 63, wr = wid >> 2, wc = wid & 3, fr = lane & 15, fq = lane >> 4;
    const int K = g.ld, nt = g.K / BK;
    unsigned voffA[2], voffB[2];
#pragma unroll
    for (int i = 0; i < 2; ++i) { int R, C; stage_rc(tid * 16 + i * 8192, R, C); const int Rb = Epi::PERM ? ((R & ~31) + perm32(R & 31)) : R;
        voffA[i] = (unsigned)(R * K + C) * 2u; voffB[i] = (unsigned)(Rb * K + C) * 2u; }
    const size_t kstep = (size_t)(BK * 2);
    const size_t hstep = (size_t)HALF * K * 2;
    const size_t tstep = 2 * hstep;
    const unsigned ldsw = (unsigned)wid * 1024u;
    const int aoff = lds_byte(wr * 64 + fr, fq * 8), boff = lds_byte(wc * 32 + fr, fq * 8);
#define PG8_SA(b, h) (((b) * 2 + (h)) * HTB)
#define PG8_SB(b, h) ((4 + (b) * 2 + (h)) * HTB)
#define PG8_STAGE(bufoff, gbase, voff) do { _Pragma("unroll") for (int _i = 0; _i < 2; ++_i) \
        __builtin_amdgcn_global_load_lds((const unsigned*)((const char*)(gbase) + (voff)[_i]), (PG8_LAS unsigned*)(lds + (bufoff) + ldsw + _i * 8192), 16, 0, 0); } while (0)
#define PG8_LDA(dst, b, h) do { _Pragma("unroll") for (int m = 0; m < 4; ++m) _Pragma("unroll") for (int k = 0; k < 2; ++k) dst[m][k] = *(const PG8_LAS bf16x8*)(lds + PG8_SA(b, h) + aoff + m * 2048 + k * 1024); } while (0)
#define PG8_LDB(dst, b, h) do { _Pragma("unroll") for (int n = 0; n < 2; ++n) _Pragma("unroll") for (int k = 0; k < 2; ++k) dst[n][k] = *(const PG8_LAS bf16x8*)(lds + PG8_SB(b, h) + boff + n * 2048 + k * 1024); } while (0)
#define PG8_MMA(ai, bj, At, Bt) do { __builtin_amdgcn_s_setprio(1); _Pragma("unroll") for (int m = 0; m < 4; ++m) _Pragma("unroll") for (int n = 0; n < 2; ++n) _Pragma("unroll") for (int k = 0; k < 2; ++k) \
        acc[ai][bj][m][n] = __builtin_amdgcn_mfma_f32_16x16x32_bf16(Bt[n][k], At[m][k], acc[ai][bj][m][n], 0, 0, 0); __builtin_amdgcn_s_setprio(0); } while (0)
#define PG8_WAIT_V(n) asm volatile("s_waitcnt vmcnt(" #n ")" ::: "memory")
#define PG8_WAIT_L(n) asm volatile("s_waitcnt lgkmcnt(" #n ")" ::: "memory")
#define PG8_BAR __builtin_amdgcn_s_barrier()
#define PG8_SCHED __builtin_amdgcn_sched_barrier(0)
    Unit cur, nxt; int ui = 0;
    if (!S.next(0, cur)) return;
    f32x4 acc[2][2][4][2];
#pragma unroll
    for (int a = 0; a < 2; ++a)
#pragma unroll
        for (int b = 0; b < 2; ++b)
#pragma unroll
            for (int m = 0; m < 4; ++m)
#pragma unroll
                for (int n = 0; n < 2; ++n) acc[a][b][m][n] = (f32x4){0.f, 0.f, 0.f, 0.f};
    bf16x8 At[4][2], B0[2][2], B1[2][2];
    const char* cA = (const char*)g.A + (size_t)cur.pm * tstep + (size_t)cur.ko * 2; const char* cB = (const char*)g.Bt + (size_t)cur.pn * tstep + (size_t)cur.ko * 2;
    S.a_ready(cur);
    if constexpr (SP2) {
        PG8_STAGE(PG8_SB(0, 0), cB, voffB); PG8_STAGE(PG8_SB(0, 1), cB + hstep, voffB); PG8_STAGE(PG8_SA(0, 0), cA, voffA); PG8_STAGE(PG8_SA(0, 1), cA + hstep, voffA);
        if (wr == 1) PG8_BAR;
        PG8_WAIT_V(2); PG8_BAR;
        PG8_STAGE(PG8_SB(1, 0), cB + kstep, voffB); PG8_STAGE(PG8_SA(1, 0), cA + kstep, voffA); PG8_STAGE(PG8_SB(1, 1), cB + hstep + kstep, voffB);
        PG8_WAIT_V(6); PG8_BAR;
    } else {
        PG8_STAGE(PG8_SB(0, 0), cB, voffB); PG8_STAGE(PG8_SA(0, 0), cA, voffA); PG8_STAGE(PG8_SB(0, 1), cB + hstep, voffB); PG8_STAGE(PG8_SA(0, 1), cA + hstep, voffA);
        if (wr == 1) PG8_BAR;
        PG8_WAIT_V(4); PG8_BAR;
        PG8_STAGE(PG8_SB(1, 0), cB + kstep, voffB); PG8_STAGE(PG8_SA(1, 0), cA + kstep, voffA); PG8_STAGE(PG8_SB(1, 1), cB + hstep + kstep, voffB);
        PG8_WAIT_V(6); PG8_BAR;
    }
    for (;;) {
        const bool has_next = S.next(ui + 1, nxt);
        const char* nA = has_next ? (const char*)g.A + (size_t)nxt.pm * tstep + (size_t)nxt.ko * 2 : cA; const char* nB = has_next ? (const char*)g.Bt + (size_t)nxt.pn * tstep + (size_t)nxt.ko * 2 : cB;
        const int nt_u = cur.sn == 2 ? (nt >> 1) : nt;
        for (int t = 0; t < nt_u; t += 2) {
            const bool last = (t == nt_u - 2);
            const char* a1 = cA + (size_t)(t + 1) * kstep;
            const char* a2 = last ? nA : cA + (size_t)(t + 2) * kstep; const char* b2 = last ? nB : cB + (size_t)(t + 2) * kstep;
            const char* a3 = a2 + kstep; const char* b3 = b2 + kstep;
            if (last && has_next) S.a_ready(nxt);
            if constexpr (SP2) {
            PG8_LDB(B0, 0, 0); PG8_LDB(B1, 0, 1); PG8_SCHED; PG8_LDA(At, 0, 0); PG8_STAGE(PG8_SA(1, 1), a1 + hstep, voffA);
            PG8_WAIT_V(8); PG8_WAIT_L(0); PG8_BAR; PG8_MMA(0, 0, At, B0); PG8_MMA(0, 1, At, B1); PG8_BAR; PG8_SCHED;
            PG8_LDA(At, 0, 1); PG8_STAGE(PG8_SB(0, 0), b2, voffB); PG8_STAGE(PG8_SB(0, 1), b2 + hstep, voffB); PG8_STAGE(PG8_SA(0, 0), a2, voffA);
            PG8_WAIT_V(8); PG8_WAIT_L(0); PG8_BAR; PG8_MMA(1, 0, At, B0); PG8_MMA(1, 1, At, B1); PG8_BAR; PG8_SCHED;
            PG8_LDB(B0, 1, 0); PG8_LDB(B1, 1, 1); PG8_SCHED; PG8_LDA(At, 1, 0); PG8_STAGE(PG8_SA(0, 1), a2 + hstep, voffA);
            PG8_WAIT_V(8); PG8_WAIT_L(0); PG8_BAR; PG8_MMA(0, 0, At, B0); PG8_MMA(0, 1, At, B1); PG8_BAR; PG8_SCHED;
            PG8_LDA(At, 1, 1); PG8_STAGE(PG8_SB(1, 0), b3, voffB); PG8_STAGE(PG8_SB(1, 1), b3 + hstep, voffB); PG8_STAGE(PG8_SA(1, 0), a3, voffA);
            PG8_WAIT_V(8); PG8_WAIT_L(0); PG8_BAR; PG8_MMA(1, 0, At, B0); PG8_MMA(1, 1, At, B1); PG8_BAR; PG8_SCHED;
            } else {
            PG8_LDB(B0, 0, 0); PG8_SCHED; PG8_LDA(At, 0, 0); PG8_STAGE(PG8_SA(1, 1), a1 + hstep, voffA);
            PG8_WAIT_L(8); PG8_BAR; PG8_WAIT_L(0); PG8_MMA(0, 0, At, B0); PG8_BAR; PG8_SCHED;
            PG8_LDB(B1, 0, 1); PG8_STAGE(PG8_SB(0, 0), b2, voffB);
            PG8_BAR; PG8_WAIT_L(0); PG8_MMA(0, 1, At, B1); PG8_BAR;
            PG8_LDA(At, 0, 1); PG8_STAGE(PG8_SA(0, 0), a2, voffA);
            PG8_BAR; PG8_WAIT_L(0); PG8_MMA(1, 0, At, B0); PG8_BAR; PG8_SCHED;
            PG8_STAGE(PG8_SB(0, 1), b2 + hstep, voffB);
            PG8_WAIT_V(6); PG8_BAR; PG8_MMA(1, 1, At, B1); PG8_BAR;
            PG8_LDB(B0, 1, 0); PG8_SCHED; PG8_LDA(At, 1, 0); PG8_STAGE(PG8_SA(0, 1), a2 + hstep, voffA);
            PG8_WAIT_L(8); PG8_BAR; PG8_WAIT_L(0); PG8_MMA(0, 0, At, B0); PG8_BAR; PG8_SCHED;
            PG8_LDB(B1, 1, 1); PG8_STAGE(PG8_SB(1, 0), b3, voffB);
            PG8_BAR; PG8_WAIT_L(0); PG8_MMA(0, 1, At, B1); PG8_BAR;
            PG8_LDA(At, 1, 1); PG8_STAGE(PG8_SA(1, 0), a3, voffA);
            PG8_BAR; PG8_WAIT_L(0); PG8_MMA(1, 0, At, B0); PG8_BAR; PG8_SCHED;
            PG8_STAGE(PG8_SB(1, 1), b3 + hstep, voffB);
            PG8_WAIT_V(6); PG8_BAR; PG8_MMA(1, 1, At, B1); PG8_BAR;
            }
        }
        if constexpr (ALIGN_EPI) { if (wr == 0) PG8_BAR; }
        if constexpr (!Epi::AFTER_DRAIN) { E(acc, cur, wr, wc, fr, fq); S.done(cur); }
        if (!has_next) break;
#pragma unroll
        for (int a = 0; a < 2; ++a)
#pragma unroll
            for (int b = 0; b < 2; ++b)
#pragma unroll
                for (int m = 0; m < 4; ++m)
#pragma unroll
                    for (int n = 0; n < 2; ++n) acc[a][b][m][n] = (f32x4){0.f, 0.f, 0.f, 0.f};
        cur = nxt; cA = nA; cB = nB; ++ui;
        if constexpr (ALIGN_EPI) { if (wr == 1) PG8_BAR; }
    }
    PG8_WAIT_V(0);
    if constexpr (!ALIGN_EPI) { if (wr == 0) PG8_BAR; }
    PG8_BAR;
    if constexpr (Epi::AFTER_DRAIN) { E.fused(acc, cur, wr, wc, fr, fq, lds, wid, lane); S.done(cur); }
#undef PG8_SA
#undef PG8_SB
#undef PG8_STAGE
#undef PG8_LDA
#undef PG8_LDB
#undef PG8_MMA
#undef PG8_WAIT_V
#undef PG8_WAIT_L
#undef PG8_BAR
#undef PG8_SCHED
}
}

typedef f32x4 AccT[2][2][4][2];
struct SchedG1 {
  pg8::StaticOrder sz, sg;
  __device__ __forceinline__ bool at(int L, pg8::Unit& u) const {
    if (L < 480) return sz.at(L, u);
    if (!sg.at(L - 480, u)) return false;
    u.pn += 15; return true;
  }
  __device__ __forceinline__ bool next(int i, pg8::Unit& u) const { return i < 3 && at(i * 256 + sz.c, u); }
  __device__ __forceinline__ void a_ready(const pg8::Unit&) const {}
  __device__ __forceinline__ void done(const pg8::Unit&) const {}
};
struct SchedOne {
  pg8::Unit u0;
  __device__ __forceinline__ bool next(int i, pg8::Unit& u) const { if (i > 0) return false; u = u0; return true; }
  __device__ __forceinline__ void a_ready(const pg8::Unit&) const {}
  __device__ __forceinline__ void done(const pg8::Unit&) const {}
};
struct SchedBr {
  pg8::StaticOrder so;
  __device__ __forceinline__ bool next(int i, pg8::Unit& u) const {
    if (i > 1 || (i == 1 && so.c >= 128)) return false;
    const int t = so.c & 127, br = i == 0 ? (so.c >> 7) : 2;
    so.at(t, u); u.pm += br * 32; u.pn += br * 4; u.sn = 3; u.slot = t; return true;
  }
  __device__ __forceinline__ void a_ready(const pg8::Unit&) const {}
  __device__ __forceinline__ void done(const pg8::Unit&) const {}
};
struct SchedSplit2 {
  pg8::StaticOrder so; int khalf_len, sn;
  __device__ __forceinline__ bool next(int i, pg8::Unit& u) const {
    if (i >= 1) return false;
    const int t = so.c & 127;
    so.at(t, u); u.ko = (so.c >> 7) * khalf_len; u.sn = sn; u.slot = t; return true;
  }
  __device__ __forceinline__ void a_ready(const pg8::Unit&) const {}
  __device__ __forceinline__ void done(const pg8::Unit&) const {}
};
struct PartRef { __amdgpu_buffer_rsrc_t rs; int voff; };
template <bool BF16P> __device__ __forceinline__ f32x4 part_ld(const PartRef& pr, int soff) {
  if (BF16P) return unpack4(__builtin_bit_cast(u32x2, __builtin_amdgcn_raw_buffer_load_b64(pr.rs, pr.voff, soff, 0)));
  return __builtin_bit_cast(f32x4, __builtin_amdgcn_raw_buffer_load_b128(pr.rs, pr.voff, soff, 0));
}
template <int NP, bool BF16P> __device__ __forceinline__ f32x4 accv(const AccT& acc, int ai, int bj, int m, int n, const PartRef& pr) {
  constexpr int PB = BF16P ? 8 : 16, IMG = 16384 * PB;
  const int q = ai * 16 + bj * 8 + m * 2 + n;
  f32x4 v = acc[ai][bj][m][n];
  if (NP >= 1) v += part_ld<BF16P>(pr, q * 512 * PB);
  if (NP >= 2) v += part_ld<BF16P>(pr, IMG + q * 512 * PB);
  return v;
}
template <class Inner, bool BF16P, int NPC>
struct EpiSplit {
  static constexpr bool PERM = Inner::PERM, AFTER_DRAIN = false;
  Inner in; char* ws; size_t part_off; int cnt_base; LAS unsigned char* ldsp; int wbase;
  __device__ __forceinline__ void operator()(AccT& acc, const pg8::Unit& u, int, int, int, int) const {
    int lane_ = lane_id(), wv_ = wbase; asm volatile("" : "+v"(lane_), "+s"(wv_));
    const int fr = lane_ & 15, fq = lane_ >> 4, wr = wv_ >> 8, wc = (wv_ >> 6) & 3;
    in.pre(acc, u, wr, wc, fr, fq);
    constexpr int PB = BF16P ? 8 : 16, IMG = 16384 * PB;
    if (u.sn == 1) { const PartRef pr0{__builtin_amdgcn_make_buffer_rsrc((void*)ws, (short)0, 0, 0x00020000), 0}; in.template fin<0, BF16P>(acc, u, wr, wc, fr, fq, pr0); return; }
    const int tid = wv_ + lane_;
    char* w_ = opq(ws);
    unsigned* c = (unsigned*)(w_ + OFF_CNT) + cnt_base + u.slot * 2;
    LAS int* role = (LAS int*)(ldsp + LDS_FLAG);
    if (tid == 0) { *role = (int)__hip_atomic_fetch_add(c, 1u, __ATOMIC_RELAXED, __HIP_MEMORY_SCOPE_AGENT); asm volatile("s_waitcnt lgkmcnt(0)" ::: "memory"); }
    __builtin_amdgcn_s_barrier(); asm volatile("" ::: "memory");
    const int r = __builtin_amdgcn_readfirstlane(*role);
    if (r < NPC) {
      const __amdgpu_buffer_rsrc_t rs = __builtin_amdgcn_make_buffer_rsrc((void*)(w_ + part_off + (size_t)(u.slot * NPC + r) * IMG), (short)0, IMG, 0x00020000);
#pragma unroll
      for (int q = 0; q < 32; ++q) {
        if (BF16P) { typedef unsigned v2u_ __attribute__((__vector_size__(2 * sizeof(unsigned)))); const u32x2 t_ = pack4(acc[q >> 4][(q >> 3) & 1][(q >> 1) & 3][q & 1]); __builtin_amdgcn_raw_buffer_store_b64(__builtin_bit_cast(v2u_, t_), rs, tid * PB, q * 512 * PB, 0); }
        else __builtin_amdgcn_raw_buffer_store_b128(__builtin_bit_cast(u32x4, acc[q >> 4][(q >> 3) & 1][(q >> 1) & 3][q & 1]), rs, tid * PB, q * 512 * PB, 0);
      }
      asm volatile("s_waitcnt vmcnt(0)" ::: "memory");
      __builtin_amdgcn_s_barrier(); asm volatile("" ::: "memory");
      if (tid == 0) {
        __builtin_amdgcn_fence(__ATOMIC_RELEASE, "agent");
        asm volatile("s_waitcnt vmcnt(0)" ::: "memory");
        (void)__hip_atomic_fetch_add(c + 1, 1u, __ATOMIC_RELAXED, __HIP_MEMORY_SCOPE_AGENT);
      }
      return;
    }
    if (tid == 0) {
      unsigned sp = 0;
      while (__hip_atomic_load(c + 1, __ATOMIC_RELAXED, __HIP_MEMORY_SCOPE_AGENT) < (unsigned)NPC) { __builtin_amdgcn_s_sleep(1); if (++sp > (1u << 22)) break; }
      __builtin_amdgcn_fence(__ATOMIC_ACQUIRE, "agent");
      asm volatile("s_waitcnt vmcnt(0)" ::: "memory");
    }
    __builtin_amdgcn_s_barrier(); asm volatile("" ::: "memory");
    const PartRef prc{__builtin_amdgcn_make_buffer_rsrc((void*)(w_ + part_off + (size_t)(u.slot * NPC) * IMG), (short)0, NPC * IMG, 0x00020000), tid * PB};
    in.template fin<NPC, BF16P>(acc, u, wr, wc, fr, fq, prc);
  }
};
struct EpiG1 {
  static constexpr bool PERM = true, AFTER_DRAIN = false;
  __device__ __forceinline__ void pre(AccT&, const pg8::Unit&, int, int, int, int) const {}
  char* ws; const float* b_gate; float* out_; int l;
  template <int NP, bool BF16P> __device__ __forceinline__ void fin(const AccT& acc, const pg8::Unit& u, int wr, int wc, int fr, int fq, const PartRef& pb) const {
    char* w_ = opq(ws); float* out = opqf(out_);
    bf16_t* Z = (bf16_t*)(w_ + OFF_Z); bf16_t* G = (bf16_t*)(w_ + OFF_G); const float* cosT = (const float*)(w_ + OFF_ROPE); const float* sinT = cosT + 1024;
    const bool lat = u.pm >= 16;
    const bool lo = fq < 2;
    const int fi = (fq & 1) * 8;
#pragma unroll
    for (int bj = 0; bj < 2; ++bj) {
      const int colg = u.pn * 256 + bj * 128 + wc * 32;
      if (colg < 3840) {
        const bool rope = lat && (colg < 1024 || (colg >= 1536 && colg < 2176));
        const bool second = (colg & 32) != 0;
        const float scl = (colg < 512 || (colg >= 1536 && colg < 2048) || (colg >= 2560 && colg < 2816)) ? 0.125f : 1.f;
        float* outp = nullptr; int outld = 0, outc = 0;
        if (!lat) {
          if (colg >= 512 && colg < 1024) { outp = out + OUT_DK; outld = 512; outc = colg - 512; }
          else if (colg >= 1024 && colg < 1536) { outp = out + OUT_DV; outld = 512; outc = colg - 1024; }
          else if (colg >= 2048 && colg < 2176) { outp = out + OUT_WK; outld = 128; outc = colg - 2048; }
          else if (colg >= 2176 && colg < 2304) { outp = out + OUT_WV; outld = 128; outc = colg - 2176; }
        }
#pragma unroll
        for (int ai = 0; ai < 2; ++ai)
#pragma unroll
          for (int m = 0; m < 4; ++m) {
            const int row = u.pm * 256 + ai * 128 + wr * 64 + m * 16 + fr;
            f32x4 v0 = accv<NP, BF16P>(acc, ai, bj, m, 0, pb), v1 = accv<NP, BF16P>(acc, ai, bj, m, 1, pb);
            if (rope) {
              const int t = (row - 4096) & 1023, pos = second ? (t & 63) : (t >> 6);
              const f32x4 ca = *(const f32x4*)(cosT + pos * 16 + fi), cb = *(const f32x4*)(cosT + pos * 16 + fi + 4);
              const f32x4 sa = *(const f32x4*)(sinT + pos * 16 + fi), sb = *(const f32x4*)(sinT + pos * 16 + fi + 4);
#pragma unroll
              for (int j = 0; j < 4; ++j) {
                const float p0 = __shfl_xor(v0[j], 32), p1 = __shfl_xor(v1[j], 32);
                v0[j] = lo ? v0[j] * ca[j] - p0 * sa[j] : p0 * sa[j] + v0[j] * ca[j];
                v1[j] = lo ? v1[j] * cb[j] - p1 * sb[j] : p1 * sb[j] + v1[j] * cb[j];
              }
            }
            if (outp) {
              float* op = outp + (size_t)(((row >> 8) * 2 + l) * 256 + (row & 255)) * outld + outc + fq * 8;
              *(f32x4*)op = v0; *(f32x4*)(op + 4) = v1;
            }
            const u32x2 a0 = pack4(v0 * scl), a1 = pack4(v1 * scl);
            *(u32x4*)(Z + (size_t)row * 3840 + colg + fq * 8) = (u32x4){a0.x, a0.y, a1.x, a1.y};
          }
      } else {
        const int gc = colg - 3840;
        const f32x4 b0 = *(const f32x4*)(b_gate + l * 3072 + gc + fq * 8), b1 = *(const f32x4*)(b_gate + l * 3072 + gc + fq * 8 + 4);
#pragma unroll
        for (int ai = 0; ai < 2; ++ai)
#pragma unroll
          for (int m = 0; m < 4; ++m) {
            const int row = u.pm * 256 + ai * 128 + wr * 64 + m * 16 + fr;
            f32x4 v0 = accv<NP, BF16P>(acc, ai, bj, m, 0, pb) + b0, v1 = accv<NP, BF16P>(acc, ai, bj, m, 1, pb) + b1;
#pragma unroll
            for (int j = 0; j < 4; ++j) { v0[j] = __builtin_amdgcn_rcpf(1.f + __expf(-v0[j])); v1[j] = __builtin_amdgcn_rcpf(1.f + __expf(-v1[j])); }
            const u32x2 a0 = pack4(v0), a1 = pack4(v1);
            *(u32x4*)(G + (size_t)row * 3072 + gc + fq * 8) = (u32x4){a0.x, a0.y, a1.x, a1.y};
          }
      }
    }
  }
};
struct EpiG2 {
  static constexpr bool PERM = true, AFTER_DRAIN = false;
  char* ws;
  __device__ __forceinline__ void pre(AccT& acc, const pg8::Unit& u, int wr, int wc, int fr, int fq) const {
    const bf16_t* G = (const bf16_t*)(opq(ws) + OFF_G);
    const int br = u.pm >> 5, pm = u.pm & 31, pn = u.pn & 3;
#pragma unroll
    for (int ai = 0; ai < 2; ++ai)
#pragma unroll
      for (int m = 0; m < 4; ++m) {
        const int row = pm * 256 + ai * 128 + wr * 64 + m * 16 + fr;
#pragma unroll
        for (int bj = 0; bj < 2; ++bj) {
          const int col = pn * 256 + bj * 128 + wc * 32 + fq * 8;
          const u32x4 g = *(const u32x4*)(G + (size_t)row * 3072 + br * 1024 + col);
          acc[ai][bj][m][0] *= unpack4((u32x2){g.x, g.y});
          acc[ai][bj][m][1] *= unpack4((u32x2){g.z, g.w});
        }
        asm volatile("" ::: "memory");
      }
  }
  template <int NP, bool BF16P> __device__ __forceinline__ void fin(const AccT& acc, const pg8::Unit& u, int wr, int wc, int fr, int fq, const PartRef& pb) const {
    bf16_t* MRG = (bf16_t*)(opq(ws) + OFF_MRG);
    const int pm = u.pm & 31, pn = u.pn & 3;
#pragma unroll
    for (int ai = 0; ai < 2; ++ai)
#pragma unroll
      for (int m = 0; m < 4; ++m) {
        const int row = pm * 256 + ai * 128 + wr * 64 + m * 16 + fr;
#pragma unroll
        for (int bj = 0; bj < 2; ++bj) {
          const int col = pn * 256 + bj * 128 + wc * 32 + fq * 8;
          const u32x2 a0 = pack4(accv<NP, BF16P>(acc, ai, bj, m, 0, pb)), a1 = pack4(accv<NP, BF16P>(acc, ai, bj, m, 1, pb));
          *(u32x4*)(MRG + (size_t)row * 1024 + col) = (u32x4){a0.x, a0.y, a1.x, a1.y};
        }
      }
  }
};
struct EpiG3 {
  static constexpr bool PERM = true, AFTER_DRAIN = false;
  char* ws; const float* xc_; const float* xl_; int l, goff;
  __device__ __forceinline__ void pre(AccT&, const pg8::Unit&, int, int, int, int) const {}
  template <int NP, bool BF16P> __device__ __forceinline__ void fin(const AccT& acc, const pg8::Unit& u, int wr, int wc, int fr, int fq, const PartRef& pb) const {
    char* w_ = opq(ws);
    const float* xc = opqf((float*)xc_); const float* xl = opqf((float*)xl_);
    const float* mod = (const float*)(w_ + OFF_MOD) + l * 5 * 6144 + goff; bf16_t* Y = (bf16_t*)(w_ + OFF_Y);
#pragma unroll
    for (int ai = 0; ai < 2; ++ai)
#pragma unroll
      for (int m = 0; m < 4; ++m) {
        const int row = u.pm * 256 + ai * 128 + wr * 64 + m * 16 + fr;
        const float* xp = row < 4096 ? xc + (size_t)row * 1024 : xl + (size_t)(row - 4096) * 1024;
        const float* gp = mod + row_group(row) * 6144;
#pragma unroll
        for (int bj = 0; bj < 2; ++bj) {
          const int col = u.pn * 256 + bj * 128 + wc * 32 + fq * 8;
          const u32x2 a0 = pack4(*(const f32x4*)(xp + col) * ALPHA_RES + *(const f32x4*)(gp + col) * accv<NP, BF16P>(acc, ai, bj, m, 0, pb));
          const u32x2 a1 = pack4(*(const f32x4*)(xp + col + 4) * ALPHA_RES + *(const f32x4*)(gp + col + 4) * accv<NP, BF16P>(acc, ai, bj, m, 1, pb));
          *(u32x4*)(Y + (size_t)row * 1024 + col) = (u32x4){a0.x, a0.y, a1.x, a1.y};
        }
      }
  }
};
struct EpiG5 {
  static constexpr bool PERM = true, AFTER_DRAIN = false;
  char* ws;
  __device__ __forceinline__ void pre(AccT&, const pg8::Unit&, int, int, int, int) const {}
  template <int NP, bool BF16P> __device__ __forceinline__ void fin(const AccT& acc, const pg8::Unit& u, int wr, int wc, int fr, int fq, const PartRef&) const {
    bf16_t* P = (bf16_t*)(opq(ws) + (u.ko ? OFF_OA : OFF_Y));
#pragma unroll
    for (int ai = 0; ai < 2; ++ai)
#pragma unroll
      for (int m = 0; m < 4; ++m) {
        const int row = u.pm * 256 + ai * 128 + wr * 64 + m * 16 + fr;
#pragma unroll
        for (int bj = 0; bj < 2; ++bj) {
          const int col = u.pn * 256 + bj * 128 + wc * 32 + fq * 8;
          const u32x2 a0 = pack4(acc[ai][bj][m][0]), a1 = pack4(acc[ai][bj][m][1]);
          *(u32x4*)(P + (size_t)row * 1024 + col) = (u32x4){a0.x, a0.y, a1.x, a1.y};
        }
      }
  }
};
struct EpiG4 {
  static constexpr bool PERM = true, AFTER_DRAIN = false;
  char* ws; int wbase;
  __device__ __forceinline__ void operator()(const AccT& acc, const pg8::Unit& u, int, int, int, int) const {
    int lane_ = lane_id(), wv_ = wbase; asm volatile("" : "+v"(lane_), "+s"(wv_));
    const int fr = lane_ & 15, fq = lane_ >> 4, wr = wv_ >> 8, wc = (wv_ >> 6) & 3;
    bf16_t* HID = (bf16_t*)(opq(ws) + OFF_HID);
#pragma unroll
    for (int ai = 0; ai < 2; ++ai)
#pragma unroll
      for (int m = 0; m < 4; ++m) {
        const int row = u.pm * 256 + ai * 128 + wr * 64 + m * 16 + fr;
#pragma unroll
        for (int bj = 0; bj < 2; ++bj) {
          const int col = u.pn * 256 + bj * 128 + wc * 32 + fq * 8;
          f32x4 v0 = acc[ai][bj][m][0], v1 = acc[ai][bj][m][1];
#pragma unroll
          for (int j = 0; j < 4; ++j) { const float r0 = fmaxf(v0[j], 0.f), r1 = fmaxf(v1[j], 0.f); v0[j] = r0 * r0; v1[j] = r1 * r1; }
          const u32x2 a0 = pack4(v0), a1 = pack4(v1);
          *(u32x4*)(HID + (size_t)row * 4096 + col) = (u32x4){a0.x, a0.y, a1.x, a1.y};
        }
      }
  }
};

__device__ void job_mod(const Params& p, int wb, int j, char* lds) {
  const int tid = otid();
  const int l = j / 96, chunk = j % 96;
  float* sil = (float*)lds;
  float* red = (float*)(lds + 20480);
  for (int i = tid; i < 5 * 1024; i += NTHR) {
    const int g = i >> 10, k = i & 1023;
    const float cv = (g == 0) ? p.c_ctx[k] : p.c[(g - 1) * 1024 + k];
    sil[i] = cv / (1.f + expf(-cv));
  }
  __syncthreads();
  const int cg4 = tid & 15, kg = tid >> 4;
  f32x4 acc[5];
#pragma unroll
  for (int g = 0; g < 5; ++g) acc[g] = (f32x4){0.f, 0.f, 0.f, 0.f};
  const float* w = p.w_mod + (size_t)l * 1024 * 6144 + chunk * 64 + cg4 * 4;
#pragma unroll 1
  for (int k0 = 0; k0 < 32; k0 += 16) {
    f32x4 wv[16];
#pragma unroll
    for (int e = 0; e < 16; ++e) wv[e] = *(const f32x4*)(w + (size_t)(kg * 32 + k0 + e) * 6144);
#pragma unroll
    for (int e = 0; e < 16; ++e)
#pragma unroll
      for (int g = 0; g < 5; ++g) acc[g] += wv[e] * sil[g * 1024 + kg * 32 + k0 + e];
  }
#pragma unroll
  for (int g = 0; g < 5; ++g) *(f32x4*)(red + (kg * 5 + g) * 64 + cg4 * 4) = acc[g];
  __syncthreads();
  float* MOD = (float*)(WS(p) + OFF_MOD);
  if (tid < 320) {
    const int g = tid >> 6, cc = tid & 63;
    float s = p.b_mod[l * 6144 + chunk * 64 + cc];
    for (int q = 0; q < 32; ++q) s += red[(q * 5 + g) * 64 + cc];
    MOD[(l * 5 + g) * 6144 + chunk * 64 + cc] = s;
  }
  __syncthreads();
}
__device__ void job_rope(const Params& p, int wb) {
  float* cosT = (float*)(WS(p) + OFF_ROPE);
  float* sinT = cosT + 1024;
  for (int t = otid(); t < 1024; t += NTHR) {
    const int pos = t >> 4, i = t & 15;
    const float inv = exp2f(-(float)i * (13.287712379549449f / 16.f));
    const float a = (float)pos * inv;
    cosT[t] = cosf(a); sinT[t] = sinf(a);
  }
}
__device__ void job_cache(const Params& p, int wb, int j) {
  const float* src; bf16_t* dst; int jj;
  if (j < 256) { src = p.cache_diff_k; dst = (bf16_t*)(WS(p) + OFF_CDK); jj = j; }
  else if (j < 512) { src = p.cache_diff_v; dst = (bf16_t*)(WS(p) + OFF_CDV); jj = j - 256; }
  else if (j < 576) { src = p.cache_win_k; dst = (bf16_t*)(WS(p) + OFF_CWK); jj = j - 512; }
  else { src = p.cache_win_v; dst = (bf16_t*)(WS(p) + OFF_CWV); jj = j - 576; }
  const size_t e = (size_t)jj * 4096 + otid() * 8;
  const f32x4 a = *(const f32x4*)(src + e), b = *(const f32x4*)(src + e + 4);
  u32x4 o; o.x = cvtpk(a[0], a[1]); o.y = cvtpk(a[2], a[3]); o.z = cvtpk(b[0], b[1]); o.w = cvtpk(b[2], b[3]);
  *(u32x4*)(dst + e) = o;
}
struct TileJob { const float* src; bf16_t* dst; int K, N, k0, n0; };
__device__ __forceinline__ TileJob tile_job(const Params& p, int l, int r) {
  TileJob t;
  if (r < 240) { t.src = p.w_in + (size_t)l * 1024 * 3840; t.K = 1024; t.N = 3840; t.dst = (bf16_t*)(WS(p) + OFF_WCAT + l * SZ_WCAT); }
  else if ((r -= 240) < 192) { t.src = p.w_gate + (size_t)l * 1024 * 3072; t.K = 1024; t.N = 3072; t.dst = (bf16_t*)(WS(p) + OFF_WCAT + l * SZ_WCAT) + (size_t)3840 * 1024; }
  else if ((r -= 192) < 32) { t.src = p.w_pa + (size_t)l * 512 * 1024; t.K = 512; t.N = 1024; t.dst = (bf16_t*)(WS(p) + OFF_WP + l * SZ_WP); }
  else if ((r -= 32) < 32) { t.src = p.w_pb + (size_t)l * 512 * 1024; t.K = 512; t.N = 1024; t.dst = (bf16_t*)(WS(p) + OFF_WP + l * SZ_WP) + (size_t)1024 * 512; }
  else if ((r -= 32) < 32) { t.src = p.w_pc + (size_t)l * 512 * 1024; t.K = 512; t.N = 1024; t.dst = (bf16_t*)(WS(p) + OFF_WP + l * SZ_WP) + (size_t)2 * 1024 * 512; }
  else if ((r -= 32) < 64) { t.src = p.w_o + (size_t)l * 1024 * 1024; t.K = 1024; t.N = 1024; t.dst = (bf16_t*)(WS(p) + OFF_WO + l * SZ_WO); }
  else if ((r -= 64) < 256) { t.src = p.w_ff1 + (size_t)l * 1024 * 4096; t.K = 1024; t.N = 4096; t.dst = (bf16_t*)(WS(p) + OFF_WF1 + l * SZ_WF); }
  else { r -= 256; t.src = p.w_ff2 + (size_t)l * 4096 * 1024; t.K = 4096; t.N = 1024; t.dst = (bf16_t*)(WS(p) + OFF_WF2 + l * SZ_WF); }
  const int ntn = t.N >> 7;
  t.k0 = (r / ntn) * 128; t.n0 = (r % ntn) * 128;
  return t;
}
__device__ __forceinline__ void tile_load(const TileJob& t, f32x4 (&v)[8], int tid) {
#pragma unroll
  for (int i = 0; i < 8; ++i) v[i] = *(const f32x4*)(t.src + (size_t)(t.k0 + (tid >> 5) + 16 * i) * t.N + t.n0 + (tid & 31) * 4);
}
__device__ __forceinline__ void tile_to_lds(const f32x4 (&v)[8], float* tile, int tid) {
#pragma unroll
  for (int i = 0; i < 8; ++i) {
    const int k = (tid >> 5) + 16 * i, n4 = (tid & 31) * 4;
    const int kb = k * 129 + (k >> 5) * 8;
    tile[kb + n4 + 0] = v[i][0]; tile[kb + n4 + 1] = v[i][1]; tile[kb + n4 + 2] = v[i][2]; tile[kb + n4 + 3] = v[i][3];
  }
}
__device__ __forceinline__ void tile_store(const TileJob& t, const float* tile, int tid) {
  const int n = tid >> 2, kc = (tid & 3) * 32, sk = (tid & 3) * 8;
  bf16_t* d = t.dst + (size_t)(t.n0 + n) * t.K + t.k0 + kc;
#pragma unroll
  for (int q = 0; q < 4; ++q) {
    u32x4 o;
    o.x = cvtpk(tile[(kc + q * 8 + 0) * 129 + sk + n], tile[(kc + q * 8 + 1) * 129 + sk + n]); o.y = cvtpk(tile[(kc + q * 8 + 2) * 129 + sk + n], tile[(kc + q * 8 + 3) * 129 + sk + n]);
    o.z = cvtpk(tile[(kc + q * 8 + 4) * 129 + sk + n], tile[(kc + q * 8 + 5) * 129 + sk + n]); o.w = cvtpk(tile[(kc + q * 8 + 6) * 129 + sk + n], tile[(kc + q * 8 + 7) * 129 + sk + n]);
    *(u32x4*)(d + q * 8) = o;
  }
}
__device__ void convert_tile(const Params& p, int wb, int l, int r, char* lds) {
  const int tid = otid();
  const TileJob t = tile_job(p, l, r);
  f32x4 v[8];
  tile_load(t, v, tid);
  tile_to_lds(v, (float*)lds, tid);
  __syncthreads();
  tile_store(t, (const float*)lds, tid);
  __syncthreads();
}
constexpr int NJ_MOD = 192, NJ_ROPE = 1, NJ_CACHE = 640, NJ_TR0 = 592;
constexpr int NJ_TOTAL = NJ_MOD + NJ_ROPE + NJ_CACHE + NJ_TR0;
__device__ void phase0(const Params& p, int wb, char* lds) {
  const int b = (int)blockIdx.x;
  if (b < NJ_MOD) job_mod(p, wb, b, lds);
  else if (b == NJ_MOD) job_rope(p, wb);
  constexpr int NREST = NJ_CACHE + NJ_TR0;
  for (int s = b; s < 320; s += (b < NJ_MOD ? 320 : 64))
    for (int r = s; r < NREST; r += 320) {
      if (r < NJ_CACHE) job_cache(p, wb, r);
      else convert_tile(p, wb, 0, r - NJ_CACHE, lds);
    }
}
constexpr int NJ_DEF = 512 + 1104, NJ_DEF_ITEMS = (NJ_DEF + 3) / 4;
__device__ __forceinline__ TileJob deferred_job(const Params& p, int j) { return j < 512 ? tile_job(p, 0, 592 + j) : tile_job(p, 1, j - 512); }
__device__ void deferred_convert(const Params& p, int wb, int j0, int j1, char* lds) {
  const int tid = otid();
  int j = j0;
  if (j >= j1) return;
  TileJob cur = deferred_job(p, j);
  f32x4 v[8];
  tile_load(cur, v, tid);
  for (;;) {
    tile_to_lds(v, (float*)lds, tid);
    __syncthreads();
    const int jn = j + 1;
    TileJob nxt = cur;
    if (jn < j1) { nxt = deferred_job(p, jn); tile_load(nxt, v, tid); }
    tile_store(cur, (const float*)lds, tid);
    __syncthreads();
    if (jn >= j1) break;
    cur = nxt; j = jn;
  }
}
__device__ void phase_h0(const Params& p, int wb) {
  const float* MOD = (const float*)(WS(p) + OFF_MOD);
  bf16_t* H = (bf16_t*)(WS(p) + OFF_H);
  for (int v = blockIdx.x * NTHR + otid(); v < 8192 * 128; v += gridDim.x * NTHR) {
    const int row = v >> 7, c8 = (v & 127) * 8;
    const float* x = (row < 4096 ? p.x_prompt + (size_t)row * 1024 : p.x_sample + (size_t)(row - 4096) * 1024) + c8;
    const float* md = MOD + row_group(row) * 6144;
    const f32x4 a = *(const f32x4*)x, b = *(const f32x4*)(x + 4);
    const f32x4 sh0 = *(const f32x4*)(md + c8), sh1 = *(const f32x4*)(md + c8 + 4);
    const f32x4 sc0 = *(const f32x4*)(md + 1024 + c8), sc1 = *(const f32x4*)(md + 1024 + c8 + 4);
    const f32x4 h0 = a * (sc0 + 1.f) + sh0, h1 = b * (sc1 + 1.f) + sh1;
    u32x4 o; o.x = cvtpk(h0[0], h0[1]); o.y = cvtpk(h0[2], h0[3]); o.z = cvtpk(h1[0], h1[1]); o.w = cvtpk(h1[2], h1[3]);
    *(u32x4*)(H + (size_t)row * 1024 + c8) = o;
  }
}

template <int KW> __device__ __forceinline__ int kaddr(int row, int ch) { return row * (KW * 2) + ((ch ^ (row & (KW / 8 - 1))) << 4); }
template <int DV> __device__ __forceinline__ int vaddr(int row, int boff) {
  if (DV == 128) return row * 256 + (boff ^ ((row & 7) << 5));
  return row * 128 + (boff ^ (((row >> 1) & 3) << 5));
}
template <int NMAPS, int DV>
__device__ __forceinline__ void attn_unit(int wbase, char* lds, const bf16_t* qp, int ldq,
                                          const bf16_t* K0, const bf16_t* V0, int ld0, int key0, int nt0,
                                          const bf16_t* K1, const bf16_t* V1, int ld1, int nt1,
                                          bool window, int qpos0, float m_init, float l_init,
                                          f32x4 (&o)[NMAPS][DV / 16], float (&lsum)[NMAPS]) {
  constexpr int KW = NMAPS * 64, NCHK = KW / 8, NKR = NCHK / 4, NVC = DV / 8, NVR = NVC / 4, KHB = 64 * KW * 2, VHB = 64 * DV * 2;
  const int tid = otid_w(wbase), lane = tid & 63, fr = lane & 15, fq = lane >> 4;
  bf16x8 qf[NMAPS][2];
#pragma unroll
  for (int mp = 0; mp < NMAPS; ++mp)
#pragma unroll
    for (int ks = 0; ks < 2; ++ks) qf[mp][ks] = *(const bf16x8*)(qp + (size_t)fr * ldq + mp * 64 + ks * 32 + fq * 8);
  float m[NMAPS], lr[NMAPS];
#pragma unroll
  for (int mp = 0; mp < NMAPS; ++mp) {
    m[mp] = m_init; lr[mp] = (fq == 0) ? l_init : 0.f;
#pragma unroll
    for (int c = 0; c < DV / 16; ++c) o[mp][c] = (f32x4){0.f, 0.f, 0.f, 0.f};
  }
  const int NT = nt0 + nt1;
  u32x4 kr[NKR], vr[NVR];
  auto load_tile = [&](int t) {
    const bf16_t* kp; const bf16_t* vp; int ld;
    if (t < nt0) { kp = K0 + (size_t)(key0 + t * 128) * ld0; vp = V0 + (size_t)(key0 + t * 128) * ld0; ld = ld0; }
    else { kp = K1 + (size_t)((t - nt0) * 128) * ld1; vp = V1 + (size_t)((t - nt0) * 128) * ld1; ld = ld1; }
#pragma unroll
    for (int i = 0; i < NKR; ++i) { const int idx = tid + NTHR * i, row = idx / NCHK, ch = idx % NCHK; kr[i] = *(const u32x4*)(kp + (size_t)row * ld + ch * 8); }
#pragma unroll
    for (int i = 0; i < NVR; ++i) { const int idx = tid + NTHR * i, row = idx / NVC, ch = idx % NVC; vr[i] = *(const u32x4*)(vp + (size_t)row * ld + ch * 8); }
  };
  load_tile(0);
  for (int t = 0; t < NT; ++t) {
    __syncthreads();
#pragma unroll
    for (int i = 0; i < NKR; ++i) { const int idx = tid + NTHR * i, row = idx / NCHK, ch = idx % NCHK; *(u32x4*)(lds + (row >> 6) * KHB + kaddr<KW>(row & 63, ch)) = kr[i]; }
#pragma unroll
    for (int i = 0; i < NVR; ++i) { const int idx = tid + NTHR * i, row = idx / NVC, ch = idx % NVC; *(u32x4*)(lds + 32768 + (row >> 6) * VHB + vaddr<DV>(row & 63, ch * 16)) = vr[i]; }
    __syncthreads();
    if (t + 1 < NT) load_tile(t + 1);
#pragma unroll
    for (int hf = 0; hf < 2; ++hf) {
      const char* kl = lds + hf * KHB;
      const char* vl = lds + 32768 + hf * VHB;
      bf16x8 pb[NMAPS][2];
#pragma unroll
      for (int mp = 0; mp < NMAPS; ++mp) {
        f32x4 s[4];
#pragma unroll
        for (int ksub = 0; ksub < 4; ++ksub) {
          s[ksub] = (f32x4){0.f, 0.f, 0.f, 0.f};
#pragma unroll
          for (int ks = 0; ks < 2; ++ks) {
            const bf16x8 kf = *(const bf16x8*)(kl + kaddr<KW>(ksub * 16 + fr, mp * 8 + ks * 4 + fq));
            s[ksub] = mfma16(kf, qf[mp][ks], s[ksub]);
          }
        }
        if (window && t < nt0) {
          const int qpos = qpos0 + fr, kb = key0 + t * 128 + hf * 64 + fq * 4;
#pragma unroll
          for (int ksub = 0; ksub < 4; ++ksub)
#pragma unroll
            for (int j = 0; j < 4; ++j) { const int d = kb + ksub * 16 + j - qpos; if (d > 128 || d < -128) s[ksub][j] = -1e30f; }
        }
        float mx = s[0][0];
#pragma unroll
        for (int ksub = 0; ksub < 4; ++ksub)
#pragma unroll
          for (int j = 0; j < 4; ++j) mx = fmaxf(mx, s[ksub][j]);
        mx = quad_max(mx);
        const float mnew = fmaxf(m[mp], mx * LOG2E);
        const float alpha = __builtin_amdgcn_exp2f(m[mp] - mnew);
        m[mp] = mnew;
        float ps = 0.f;
#pragma unroll
        for (int ksub = 0; ksub < 4; ++ksub)
#pragma unroll
          for (int j = 0; j < 4; ++j) { const float pv = __builtin_amdgcn_exp2f(s[ksub][j] * LOG2E - mnew); s[ksub][j] = pv; ps += pv; }
        lr[mp] = lr[mp] * alpha + ps;
        if (__any(alpha != 1.f)) {
#pragma unroll
          for (int c = 0; c < DV / 16; ++c) o[mp][c] *= alpha;
        }
#pragma unroll
        for (int kk = 0; kk < 2; ++kk) {
          u32x4 w; w.x = cvtpk(s[2 * kk][0], s[2 * kk][1]); w.y = cvtpk(s[2 * kk][2], s[2 * kk][3]);
          w.z = cvtpk(s[2 * kk + 1][0], s[2 * kk + 1][1]); w.w = cvtpk(s[2 * kk + 1][2], s[2 * kk + 1][3]);
          pb[mp][kk] = __builtin_bit_cast(bf16x8, w);
        }
      }
#pragma unroll
      for (int c = 0; c < DV / 16; ++c)
#pragma unroll
        for (int kk = 0; kk < 2; ++kk) {
          const int vrow = kk * 32 + fq * 4 + (fr >> 2), vb = (c * 16 + (lane & 3) * 4) * 2;
          const s16x4 lo = vtr(vl + vaddr<DV>(vrow, vb));
          const s16x4 hi = vtr(vl + vaddr<DV>(vrow + 16, vb));
          const bf16x8 vf = cat8(lo, hi);
#pragma unroll
          for (int mp = 0; mp < NMAPS; ++mp) o[mp][c] = mfma16(vf, pb[mp][kk], o[mp][c]);
        }
    }
  }
#pragma unroll
  for (int mp = 0; mp < NMAPS; ++mp) lsum[mp] = quad_sum(lr[mp]);
}

__device__ void unitA(const Params& p, int wb, int l, char* lds, int b_all, int h, int qb) {
  const bf16_t* Z = (const bf16_t*)(WS(p) + OFF_Z);
  const int tid = otid(), lane = tid & 63, wid = tid >> 6, fr = lane & 15, fq = lane >> 4;
  const bool lat = b_all >= 16; const int b = lat ? b_all - 16 : b_all;
  const int rowbase = lat ? 4096 + b * 1024 : b * 256;
  const int q0 = qb * 128 + wid * 16;
  const bf16_t* qp = Z + (size_t)(rowbase + q0) * 3840 + h * 128;
  const bf16_t* K0 = Z + (size_t)rowbase * 3840 + 512 + h * 128;
  const bf16_t* V0 = Z + (size_t)rowbase * 3840 + 1024 + h * 128;
  const bf16_t* K1 = (const bf16_t*)(WS(p) + OFF_CDK) + (size_t)((b * 2 + l) * 256) * 512 + h * 128;
  const bf16_t* V1 = (const bf16_t*)(WS(p) + OFF_CDV) + (size_t)((b * 2 + l) * 256) * 512 + h * 128;
  f32x4 o[2][8]; float ls[2];
  attn_unit<2, 128>(wb, lds, qp, 3840, K0, V0, 3840, 0, lat ? 8 : 2, K1, V1, 512, lat ? 2 : 0, false, 0, -1e30f, 0.f, o, ls);
  const float* lv = p.diff_lam + l * 256;
  const float d1 = wave_sum(lv[lane] * lv[64 + lane]), d2 = wave_sum(lv[128 + lane] * lv[192 + lane]);
  const float lam_init = p.lam_init[l];
  const float lam = expf(d1) - expf(d2) + lam_init;
  const float i0 = 1.f / ls[0], i1 = lam / ls[1];
  float ss = 0.f;
#pragma unroll
  for (int c = 0; c < 8; ++c) {
    o[0][c] = o[0][c] * i0 - o[1][c] * i1;
#pragma unroll
    for (int j = 0; j < 4; ++j) ss += o[0][c][j] * o[0][c][j];
  }
  ss = quad_sum(ss);
  const float r = rsqrtf(ss * (1.f / 128.f) + LN_EPS) * (1.f - lam_init);
  bf16_t* OA = (bf16_t*)(WS(p) + OFF_OA) + (size_t)(rowbase + q0 + fr) * 512 + h * 128 + fq * 4;
  const float* gn = p.diff_norm_g + l * 128 + fq * 4;
#pragma unroll
  for (int c = 0; c < 8; ++c) { const f32x4 g = *(const f32x4*)(gn + c * 16); *(u32x2*)(OA + c * 16) = pack4(o[0][c] * g * r); }
}
__device__ void unitB(const Params& p, int wb, int l, char* lds, int b_all, int kvh, int qb) {
  const bf16_t* Z = (const bf16_t*)(WS(p) + OFF_Z);
  const int tid = otid(), lane = tid & 63, wid = tid >> 6, fr = lane & 15, fq = lane >> 4;
  const bool lat = b_all >= 16; const int b = lat ? b_all - 16 : b_all;
  const int rowbase = lat ? 4096 + b * 1024 : b * 256;
  const int q0b = qb * 32, q0 = q0b + (wid >> 2) * 16, head = kvh * 4 + (wid & 3);
  const bf16_t* qp = Z + (size_t)(rowbase + q0) * 3840 + 1536 + head * 64;
  const bf16_t* K0 = Z + (size_t)rowbase * 3840 + 2048 + kvh * 64;
  const bf16_t* V0 = Z + (size_t)rowbase * 3840 + 2176 + kvh * 64;
  const bf16_t* K1 = (const bf16_t*)(WS(p) + OFF_CWK) + (size_t)((b * 2 + l) * 256) * 128 + kvh * 64;
  const bf16_t* V1 = (const bf16_t*)(WS(p) + OFF_CWV) + (size_t)((b * 2 + l) * 256) * 128 + kvh * 64;
  int key0 = 0, nt0 = 2, nt1 = 0;
  if (lat) {
    const int lo = q0b - 128 < 0 ? 0 : q0b - 128, hi = q0b + 159 > 1023 ? 1023 : q0b + 159;
    key0 = (lo >> 7) << 7; nt0 = (hi >> 7) - (lo >> 7) + 1; nt1 = 2;
  }
  const float sink = p.win_sink[l * 8 + head];
  f32x4 o[1][4]; float ls[1];
  attn_unit<1, 64>(wb, lds, qp, 3840, K0, V0, 3840, key0, nt0, K1, V1, 128, nt1, lat, q0, sink * LOG2E, 1.f, o, ls);
  const float inv = 1.f / ls[0];
  bf16_t* OB = (bf16_t*)(WS(p) + OFF_OB) + (size_t)(rowbase + q0 + fr) * 512 + head * 64 + fq * 4;
#pragma unroll
  for (int c = 0; c < 4; ++c) *(u32x2*)(OB + c * 16) = pack4(o[0][c] * inv);
}

__device__ void unitC(const Params& p, int wb, int l, char* lds, int b_all, int h, int dir) {
  const bf16_t* Z = (const bf16_t*)(WS(p) + OFF_Z);
  float* YF = (float*)(WS(p) + (dir ? OFF_YB : OFF_MRG));
  const int tid = otid(), lane = tid & 63, fr = lane & 15, fq = lane >> 4;
  const int wave = __builtin_amdgcn_readfirstlane(tid >> 6);
  const bool lat = b_all >= 16; const int b = lat ? b_all - 16 : b_all;
  const int rowbase = lat ? 4096 + b * 1024 : b * 256, nc = lat ? 8 : 2;
  {
    const float xd = p.ret_decay[(l * 2 + dir) * 4 + h];
    const float lg2 = -log2f(1.f + expf(-xd));
    const float g128 = exp2f(128.f * lg2);
    f32x4 st[4];
    if (lat) {
      const float* s0 = p.state_ret + (size_t)((((b * 2 + l) * 2 + dir) * 4 + h)) * 8192;
#pragma unroll
      for (int bb = 0; bb < 4; ++bb) st[bb] = *(const f32x4*)(s0 + (bb * 16 + fr) * 128 + wave * 16 + fq * 4);
    } else {
#pragma unroll
      for (int bb = 0; bb < 4; ++bb) st[bb] = (f32x4){0.f, 0.f, 0.f, 0.f};
    }
    u32x4 kzr[2], vr4[4];
    auto load_chunk = [&](int cc_) {
      const int rr = rowbase + (dir ? nc - 1 - cc_ : cc_) * 128;
#pragma unroll
      for (int i = 0; i < 2; ++i) { const int idx = tid + NTHR * i, row = idx >> 3, ch = idx & 7; kzr[i] = *(const u32x4*)(Z + (size_t)(rr + row) * 3840 + 2560 + h * 64 + ch * 8); }
#pragma unroll
      for (int i = 0; i < 4; ++i) { const int idx = tid + NTHR * i, row = idx >> 4, ch = idx & 15; vr4[i] = *(const u32x4*)(Z + (size_t)(rr + row) * 3840 + 2816 + h * 128 + ch * 8); }
    };
    load_chunk(0);
#pragma unroll 1
    for (int cc = 0; cc < nc; ++cc) {
      const int c = dir ? nc - 1 - cc : cc;
      const int r0 = rowbase + c * 128;
      __syncthreads();
#pragma unroll
      for (int bb = 0; bb < 4; ++bb) {
        st[bb] *= g128;
        *(u32x2*)(lds + 16384 + vaddr<128>(bb * 16 + fr, (wave * 16 + fq * 4) * 2)) = pack4(st[bb]);
      }
#pragma unroll
      for (int i = 0; i < 2; ++i) {
        const int idx = tid + NTHR * i, row = idx >> 3, ch = idx & 7;
        const u32x4 v = kzr[i];
        const float zeta = exp2f(lg2 * (float)(dir ? row : 127 - row));
        u32x4 w;
        w.x = cvtpk(bflo(v.x) * zeta, bfhi(v.x) * zeta); w.y = cvtpk(bflo(v.y) * zeta, bfhi(v.y) * zeta);
        w.z = cvtpk(bflo(v.z) * zeta, bfhi(v.z) * zeta); w.w = cvtpk(bflo(v.w) * zeta, bfhi(v.w) * zeta);
        *(u32x4*)(lds + row * 128 + ((ch ^ (row & 7)) << 4)) = w;
      }
#pragma unroll
      for (int i = 0; i < 4; ++i) {
        const int idx = tid + NTHR * i, row = idx >> 4, ch = idx & 15;
        *(u32x4*)(lds + 32768 + vaddr<128>(row, ch * 16)) = vr4[i];
      }
      __syncthreads();
      if (cc + 1 < nc) load_chunk(cc + 1);
      {
        const int qw0 = wave * 16;
        const bf16_t* qbase = Z + (size_t)(r0 + qw0 + fr) * 3840 + 2304 + h * 64;
        f32x4 acc[8];
        {
          bf16x8 qx[2];
#pragma unroll
          for (int ks = 0; ks < 2; ++ks) {
            const u32x2 lo = *(const u32x2*)(qbase + ks * 32 + fq * 4);
            const u32x2 hi = *(const u32x2*)(qbase + ks * 32 + 16 + fq * 4);
            u32x4 w; w.x = lo.x; w.y = lo.y; w.z = hi.x; w.w = hi.y;
            qx[ks] = __builtin_bit_cast(bf16x8, w);
          }
#pragma unroll
          for (int c8 = 0; c8 < 8; ++c8) {
            acc[c8] = (f32x4){0.f, 0.f, 0.f, 0.f};
#pragma unroll
            for (int ks = 0; ks < 2; ++ks) {
              const int srow = ks * 32 + fq * 4 + (fr >> 2), sb = (c8 * 16 + (lane & 3) * 4) * 2;
              const bf16x8 sf = cat8(vtr(lds + 16384 + vaddr<128>(srow, sb)), vtr(lds + 16384 + vaddr<128>(srow + 16, sb)));
              acc[c8] = mfma16(sf, qx[ks], acc[c8]);
            }
          }
        }
        bf16x8 qf[2];
#pragma unroll
        for (int ks = 0; ks < 2; ++ks) qf[ks] = *(const bf16x8*)(qbase + ks * 32 + fq * 8);
#pragma unroll
        for (int kk = 0; kk < 4; ++kk) {
          if (dir == 0 ? (kk * 32 > qw0 + 15) : (kk * 32 + 31 < qw0)) continue;
          f32x4 s0 = (f32x4){0.f, 0.f, 0.f, 0.f}, s1 = (f32x4){0.f, 0.f, 0.f, 0.f};
#pragma unroll
          for (int ks = 0; ks < 2; ++ks) {
            const int co = ((ks * 4 + fq) ^ (fr & 7)) << 4;
            const bf16x8 k0f = *(const bf16x8*)(lds + (kk * 32 + fr) * 128 + co);
            const bf16x8 k1f = *(const bf16x8*)(lds + (kk * 32 + 16 + fr) * 128 + co);
            s0 = mfma16(k0f, qf[ks], s0); s1 = mfma16(k1f, qf[ks], s1);
          }
          const int qtok = qw0 + fr, kt0 = kk * 32 + fq * 4;
#pragma unroll
          for (int j = 0; j < 4; ++j) {
            const int ka = kt0 + j, kb = kt0 + 16 + j;
            const bool keepa = dir == 0 ? (ka <= qtok) : (ka >= qtok);
            const bool keepb = dir == 0 ? (kb <= qtok) : (kb >= qtok);
            s0[j] = keepa ? s0[j] : 0.f; s1[j] = keepb ? s1[j] : 0.f;
          }
          u32x4 w; w.x = cvtpk(s0[0], s0[1]); w.y = cvtpk(s0[2], s0[3]); w.z = cvtpk(s1[0], s1[1]); w.w = cvtpk(s1[2], s1[3]);
          const bf16x8 pb = __builtin_bit_cast(bf16x8, w);
#pragma unroll
          for (int c8 = 0; c8 < 8; ++c8) {
            const int vrow = kk * 32 + fq * 4 + (fr >> 2), vb = (c8 * 16 + (lane & 3) * 4) * 2;
            const bf16x8 vf = cat8(vtr(lds + 32768 + vaddr<128>(vrow, vb)), vtr(lds + 32768 + vaddr<128>(vrow + 16, vb)));
            acc[c8] = mfma16(vf, pb, acc[c8]);
          }
        }
        {
          const int qtok = qw0 + fr;
          const float rowfac = exp2f(lg2 * (float)(dir ? -qtok : qtok - 127));
          const int row = r0 + qtok;
          float* yp = YF + (size_t)row * 512 + h * 128 + fq * 4;
#pragma unroll
          for (int c8 = 0; c8 < 8; ++c8) *(f32x4*)(yp + c8 * 16) = acc[c8] * rowfac;
        }
      }
#pragma unroll
      for (int kk = 0; kk < 4; ++kk) {
        const int trow = kk * 32 + fq * 4 + (fr >> 2);
        bf16x8 kz[4];
#pragma unroll
        for (int bb = 0; bb < 4; ++bb) {
          const int col = bb * 16 + (lane & 3) * 4;
          const s16x4 lo = vtr(lds + trow * 128 + (((col >> 3) ^ (trow & 7)) << 4) + (col & 7) * 2);
          const s16x4 hi = vtr(lds + (trow + 16) * 128 + (((col >> 3) ^ (trow & 7)) << 4) + (col & 7) * 2);
          kz[bb] = cat8(lo, hi);
        }
        const int vb = (wave * 16 + (lane & 3) * 4) * 2;
        const bf16x8 vt = cat8(vtr(lds + 32768 + vaddr<128>(trow, vb)), vtr(lds + 32768 + vaddr<128>(trow + 16, vb)));
#pragma unroll
        for (int bb = 0; bb < 4; ++bb) st[bb] = mfma16(vt, kz[bb], st[bb]);
      }
    }
    if (!lat) {
      float* dst = OUTP(p) + OUT_ST + (size_t)((((b * 2 + l) * 2 + dir) * 4 + h)) * 8192;
#pragma unroll
      for (int bb = 0; bb < 4; ++bb) *(f32x4*)(dst + (bb * 16 + fr) * 128 + wave * 16 + fq * 4) = st[bb];
    }
  }
  asm volatile("s_waitcnt vmcnt(0)" ::: "memory");
  __syncthreads();
  if (tid == 0) {
    __builtin_amdgcn_fence(__ATOMIC_RELEASE, "agent");
    asm volatile("s_waitcnt vmcnt(0)" ::: "memory");
    (void)__hip_atomic_fetch_add((unsigned*)(WS(p) + OFF_CNT) + 64 + (l * 20 + b_all) * 4 + h, 1u, __ATOMIC_RELAXED, __HIP_MEMORY_SCOPE_AGENT);
  }
}
__device__ void unitCF(const Params& p, int wb, int l, char* lds, int b_all, int h, int tb) {
  const int tid = otid(), lane = tid & 63, wid = tid >> 6;
  if (tid == 0) {
    unsigned* dn = (unsigned*)(WS(p) + OFF_CNT) + 64 + (l * 20 + b_all) * 4 + h;
    unsigned sp = 0;
    while (__hip_atomic_load(dn, __ATOMIC_RELAXED, __HIP_MEMORY_SCOPE_AGENT) < 2u) { __builtin_amdgcn_s_sleep(2); if (++sp > (1u << 22)) break; }
    __builtin_amdgcn_fence(__ATOMIC_ACQUIRE, "agent");
    asm volatile("s_waitcnt vmcnt(0)" ::: "memory");
  }
  __syncthreads();
  const bf16_t* Z = (const bf16_t*)(WS(p) + OFF_Z);
  const float* YF = (const float*)(WS(p) + OFF_MRG);
  const float* YB = (const float*)(WS(p) + OFF_YB);
  bf16_t* OC = (bf16_t*)(WS(p) + OFF_OC);
  const bool lat = b_all >= 16; const int b = lat ? b_all - 16 : b_all;
  const int row0 = (lat ? 4096 + b * 1024 : b * 256) + tb * 256 + wid * 32;
  const float g0 = p.ret_norm_g[l * 128 + lane * 2], g1 = p.ret_norm_g[l * 128 + lane * 2 + 1];
#pragma unroll 4
  for (int i = 0; i < 32; ++i) {
    const size_t ro = (size_t)(row0 + i) * 512 + h * 128 + lane * 2;
    const f32x2_t a = *(const f32x2_t*)(YF + ro), bq = *(const f32x2_t*)(YB + ro);
    const unsigned cgu = *(const unsigned*)(Z + (size_t)(row0 + i) * 3840 + 3328 + h * 128 + lane * 2);
    float y0 = a.x + bq.x, y1 = a.y + bq.y;
    const float mu = wave_sum(y0 + y1) * (1.f / 128.f);
    y0 -= mu; y1 -= mu;
    const float rstd = rsqrtf(wave_sum(y0 * y0 + y1 * y1) * (1.f / 128.f) + LN_EPS);
    const float c0 = bflo(cgu), c1 = bfhi(cgu);
    const float s0 = c0 * __builtin_amdgcn_rcpf(1.f + __expf(-c0)), s1 = c1 * __builtin_amdgcn_rcpf(1.f + __expf(-c1));
    *(unsigned*)(OC + ro) = cvtpk(y0 * rstd * g0 * s0, y1 * rstd * g1 * s1);
  }
}

#define PG8_FLAGS true, true
__device__ void phase_att(const Params& p, int wb, int l, char* lds, LAS unsigned char* ldsg) {
  unsigned* cnt = (unsigned*)(WS(p) + OFF_CNT) + l;
  for (;;) {
    __syncthreads();
    if (otid() == 0) *(int*)(lds + LDS_FLAG) = (int)atomicAdd(cnt, 1u);
    __syncthreads();
    const int u = __builtin_amdgcn_readfirstlane(*(const int*)(lds + LDS_FLAG));
    if (u >= 1152) break;
    if (u < 32) unitC(p, wb, l, lds, 16 + (u >> 3), (u >> 1) & 3, u & 1);
    else if (u < 160) { const int v = u - 32; unitA(p, wb, l, lds, 16 + (v >> 5), (v >> 3) & 3, v & 7); }
    else if (u < 256) {
      pg8::Gemm g{(const bf16_t*)(WS(p) + OFF_H), (const bf16_t*)(WS(p) + OFF_WCAT + l * SZ_WCAT), 1024, 1024};
      SchedG1 SG; SG.sz.init(8192, 3840, (int)gridDim.x, 0, 16); SG.sg.init(8192, 3072, (int)gridDim.x, 0, 16);
      SchedOne S1; SG.at(768 + (u - 160), S1.u0);
      EpiSplit<EpiG1, false, 1> E{EpiG1{p.ws, p.b_gate, p.out, l}, p.ws, OFF_OA, 256 + l * 1024, ldsg, wb};
      pg8::gemm_phase<EpiSplit<EpiG1, false, 1>, SchedOne, PG8_FLAGS>(ldsg, g, S1, E, wb);
    }
    else if (u < 384) { const int v = u - 256; unitC(p, wb, l, lds, v >> 3, (v >> 1) & 3, v & 1); }
    else if (u < 512) { const int v = u - 384; unitA(p, wb, l, lds, v >> 3, (v >> 1) & 3, v & 1); }
    else if (u < 768) { const int v = u - 512; unitB(p, wb, l, lds, 16 + (v >> 6), (v >> 5) & 1, v & 31); }
    else if (u < 1024) { const int v = u - 768; unitB(p, wb, l, lds, v >> 4, (v >> 3) & 1, v & 7); }
    else if (u < 1088) { const int v = u - 1024; unitCF(p, wb, l, lds, 16 + (v >> 4), (v >> 2) & 3, v & 3); }
    else { const int v = u - 1088; unitCF(p, wb, l, lds, v >> 2, v & 3, 0); }
  }
}

template <bool COMBINE, int NR>
__device__ void ln_rows(const Params& p, int wb, int row_lo, int row_hi, const float* Y, const float* P1, const float* gate, const float* g, const float* bta, const float* md, int sh_off, int sc_off) {
  float* X = OUTP(p) + OUT_X;
  bf16_t* H = (bf16_t*)(WS(p) + OFF_H);
  const int tid = otid(), lane = tid & 63, wid = tid >> 6;
  for (int row0 = row_lo + wid * NR; row0 < row_hi; row0 += 8 * NR) {
    f32x4 v[NR][4];
    if (!COMBINE) {
#pragma unroll
      for (int r = 0; r < NR; ++r)
#pragma unroll
        for (int k = 0; k < 2; ++k) {
          const u32x4 w = *(const u32x4*)((const bf16_t*)Y + (size_t)(row0 + r) * 1024 + k * 512 + lane * 8);
          v[r][2 * k] = unpack4((u32x2){w.x, w.y}); v[r][2 * k + 1] = unpack4((u32x2){w.z, w.w});
        }
    } else {
      const bf16_t* Yb = (const bf16_t*)Y; const bf16_t* Pb = (const bf16_t*)P1;
#pragma unroll
      for (int r = 0; r < NR; ++r)
#pragma unroll
        for (int k = 0; k < 2; ++k) {
          const int cb = k * 512 + lane * 8;
          const u32x4 w0 = *(const u32x4*)(Yb + (size_t)(row0 + r) * 1024 + cb), w1 = *(const u32x4*)(Pb + (size_t)(row0 + r) * 1024 + cb);
          const f32x4 fa = unpack4((u32x2){w0.x, w0.y}) + unpack4((u32x2){w1.x, w1.y}), fb = unpack4((u32x2){w0.z, w0.w}) + unpack4((u32x2){w1.z, w1.w});
          const float* xr = X + (size_t)(row0 + r) * 1024 + cb; const float* gr = gate + row_group(row0 + r) * 6144 + cb;
          v[r][2 * k] = *(const f32x4*)xr * ALPHA_RES + *(const f32x4*)gr * fa;
          v[r][2 * k + 1] = *(const f32x4*)(xr + 4) * ALPHA_RES + *(const f32x4*)(gr + 4) * fb;
        }
    }
#pragma unroll
    for (int r = 0; r < NR; ++r) {
      const int row = row0 + r;
      float s = 0.f;
#pragma unroll
      for (int i = 0; i < 4; ++i) s += (v[r][i][0] + v[r][i][1]) + (v[r][i][2] + v[r][i][3]);
      const float mu = wave_sum(s) * (1.f / 1024.f);
      float q = 0.f;
#pragma unroll
      for (int i = 0; i < 4; ++i) { v[r][i] = v[r][i] - mu; q += (v[r][i][0] * v[r][i][0] + v[r][i][1] * v[r][i][1]) + (v[r][i][2] * v[r][i][2] + v[r][i][3] * v[r][i][3]); }
      const float rstd = rsqrtf(wave_sum(q) * (1.f / 1024.f) + LN_EPS);
      const float* mrow = md ? md + row_group(row) * 6144 : nullptr;
#pragma unroll
      for (int k = 0; k < 2; ++k) {
        const int cb = k * 512 + lane * 8;
        const f32x4 x0 = v[r][2 * k] * rstd * *(const f32x4*)(g + cb) + *(const f32x4*)(bta + cb);
        const f32x4 x1 = v[r][2 * k + 1] * rstd * *(const f32x4*)(g + cb + 4) + *(const f32x4*)(bta + cb + 4);
        *(f32x4*)(X + (size_t)row * 1024 + cb) = x0; *(f32x4*)(X + (size_t)row * 1024 + cb + 4) = x1;
        if (mrow) {
          const f32x4 h0 = x0 * (*(const f32x4*)(mrow + sc_off + cb) + 1.f) + *(const f32x4*)(mrow + sh_off + cb);
          const f32x4 h1 = x1 * (*(const f32x4*)(mrow + sc_off + cb + 4) + 1.f) + *(const f32x4*)(mrow + sh_off + cb + 4);
          const u32x2 a0 = pack4(h0), a1 = pack4(h1);
          *(u32x4*)(H + (size_t)row * 1024 + cb) = (u32x4){a0.x, a0.y, a1.x, a1.y};
        }
      }
    }
  }
}
template <bool COMBINE, int NR>
__device__ void phase_ln(const Params& p, int wb, const float* Y, const float* P1, const float* gate, const float* g, const float* bta, const float* md, int sh_off, int sc_off) {
  const int rpb = 8192 / (int)gridDim.x;
  ln_rows<COMBINE, NR>(p, wb, (int)blockIdx.x * rpb, ((int)blockIdx.x + 1) * rpb, Y, P1, gate, g, bta, md, sh_off, sc_off);
}

#define XB_TMO      128
#define XB_XCNT(j)  (256  + 64 * (j))
#define XB_XSUB(j)  (1280 + 64 * (j))
#define XB_XGEN(j)  (2304 + 64 * (j))
#define XB_TOP      3328
#define XB_TOPGEN   3392
#define XCD_BAR_WORDS 3456
#define XB_SPIN_CAP (1u << 18)
__device__ __forceinline__ unsigned xb_ld(unsigned* p)              { return __hip_atomic_load(p, __ATOMIC_RELAXED, __HIP_MEMORY_SCOPE_AGENT); }
__device__ __forceinline__ unsigned xb_add(unsigned* p, unsigned v) { return __hip_atomic_fetch_add(p, v, __ATOMIC_RELAXED, __HIP_MEMORY_SCOPE_AGENT); }
__device__ __forceinline__ unsigned xb_xcc_id() { return (unsigned)__builtin_amdgcn_s_getreg((3 << 11) | 20) & 0xFu; }
#define XB_SPIN(cond, bar) do { unsigned _sp = 0; while (cond) { __builtin_amdgcn_s_sleep(1); \
    if ((++_sp & 255u) == 0u) { if (xb_ld(&(bar)[XB_TMO])) break; if (_sp > XB_SPIN_CAP) { atomicAdd(&(bar)[XB_TMO], 1u); break; } } } } while (0)
__device__ __forceinline__ void xcd_barrier_post(unsigned* bar, bool t0) { if (t0) (void)xb_add(&bar[XB_XCNT(xb_xcc_id())], 1u); }
__device__ __forceinline__ void xcd_barrier_complete(unsigned* bar, unsigned x, unsigned& nloc, unsigned& nx) {
    const unsigned G = gridDim.x * gridDim.y * gridDim.z;
    unsigned sum, cnt, mine, sp = 0u;
    for (;;) {
        sum = 0u; cnt = 0u; mine = 0u;
#pragma unroll
        for (unsigned j = 0; j < 16; ++j) { const unsigned c = xb_ld(&bar[XB_XCNT(j)]); sum += c; cnt += (c > 0u) ? 1u : 0u; mine = (j == x) ? c : mine; }
        if (sum == G) break;
        __builtin_amdgcn_s_sleep(1);
        if ((++sp & 255u) == 0u) { if (xb_ld(&bar[XB_TMO])) break; if (sp > XB_SPIN_CAP) { atomicAdd(&bar[XB_TMO], 1u); break; } }
    }
    nloc = mine > 0u ? mine : 1u; nx = cnt > 0u ? cnt : 1u;
}
__device__ __forceinline__ void xcd_barrier(unsigned* bar, volatile LAS unsigned* st, bool t0) {
    asm volatile("s_waitcnt vmcnt(0)" ::: "memory");
    __syncthreads();
    if (t0) {
        const unsigned x = xb_xcc_id();
        __builtin_amdgcn_s_waitcnt(0);
        unsigned nloc = st[0], nx = st[1];
        if (nloc == 0u) { xcd_barrier_complete(bar, x, nloc, nx); st[0] = nloc; st[1] = nx; }
        const unsigned old = xb_add(&bar[XB_XSUB(x)], 1u);
        const unsigned gen = old / nloc;
        if (old + 1u == (gen + 1u) * nloc) {
            __builtin_amdgcn_fence(__ATOMIC_RELEASE, "agent");
            asm volatile("s_waitcnt vmcnt(0)" ::: "memory");
            const unsigned og = xb_add(&bar[XB_TOP], 1u);
            const unsigned tg = og / nx;
            if (og + 1u == (tg + 1u) * nx) xb_add(&bar[XB_TOPGEN], 1u);
            else XB_SPIN(xb_ld(&bar[XB_TOPGEN]) == tg, bar);
            __builtin_amdgcn_fence(__ATOMIC_ACQUIRE, "agent");
            xb_add(&bar[XB_XGEN(x)], 1u);
            asm volatile("s_waitcnt vmcnt(0)" ::: "memory");
        } else {
            XB_SPIN(xb_ld(&bar[XB_XGEN(x)]) == gen, bar);
            __builtin_amdgcn_fence(__ATOMIC_ACQUIRE, "agent");
            asm volatile("s_waitcnt vmcnt(0)" ::: "memory");
        }
    }
    __syncthreads();
}
#define GRID_BAR() xcd_barrier((unsigned*)(WS(p) + OFF_BAR), (volatile LAS unsigned*)(ldsg + LDS_ST), otid() == 0)

__global__ void __launch_bounds__(NTHR, 2) fwd_megakernel(Params p) {
  const int wb = __builtin_amdgcn_readfirstlane((int)threadIdx.x) & ~63;
  cg::grid_group grid = cg::this_grid();
  extern __shared__ __attribute__((aligned(16))) unsigned char lds_dyn[];
  char* lds = (char*)lds_dyn;
  LAS unsigned char* ldsg = (LAS unsigned char*)lds_dyn;
  if (p.ws == nullptr) grid.sync();
  { const int t_ = otid(); if (t_ < 4) ((LAS unsigned*)(ldsg + LDS_ST))[t_] = 0u; __syncthreads(); xcd_barrier_post((unsigned*)(WS(p) + OFF_BAR), t_ == 0); }
  phase0(p, wb, lds);
  GRID_BAR();
  phase_h0(p, wb);
  GRID_BAR();
#pragma unroll 1
  for (int l = 0; l < 2; ++l) {
    {
      pg8::Gemm g{(const bf16_t*)(WS(p) + OFF_H), (const bf16_t*)(WS(p) + OFF_WCAT + l * SZ_WCAT), 1024, 1024};
      SchedG1 S; S.sz.init(8192, 3840, (int)gridDim.x, (int)blockIdx.x, 16); S.sg.init(8192, 3072, (int)gridDim.x, (int)blockIdx.x, 16);
      EpiSplit<EpiG1, false, 1> E{EpiG1{p.ws, p.b_gate, p.out, l}, p.ws, OFF_OA, 256 + l * 1024, ldsg, wb};
      pg8::gemm_phase<EpiSplit<EpiG1, false, 1>, SchedG1, PG8_FLAGS>(ldsg, g, S, E, wb);
    }
    GRID_BAR();
    phase_att(p, wb, l, lds, ldsg);
    GRID_BAR();
    {
      pg8::Gemm g{(const bf16_t*)(WS(p) + OFF_OA), (const bf16_t*)(WS(p) + OFF_WP + l * SZ_WP), 512, 512};
      SchedBr S; S.so.init(8192, 1024, (int)gridDim.x, (int)blockIdx.x, 8);
      EpiSplit<EpiG2, true, 2> E{EpiG2{p.ws}, p.ws, OFF_Z, 256 + l * 1024 + 256, ldsg, wb};
      pg8::gemm_phase<EpiSplit<EpiG2, true, 2>, SchedBr, PG8_FLAGS>(ldsg, g, S, E, wb);
      if (l == 0 && blockIdx.x >= 128) { const int i0 = ((int)blockIdx.x - 128) * 5; deferred_convert(p, wb, i0, i0 + 5, lds); }
    }
    GRID_BAR();
    {
      pg8::Gemm g{(const bf16_t*)(WS(p) + OFF_MRG), (const bf16_t*)(WS(p) + OFF_WO + l * SZ_WO), 1024, 1024};
      pg8::StaticOrder S; S.init(8192, 1024, (int)gridDim.x, (int)blockIdx.x, 16);
      const float* xc = l == 0 ? p.x_prompt : p.out + OUT_X;
      const float* xl = l == 0 ? p.x_sample : p.out + OUT_X + (size_t)4096 * 1024;
      EpiSplit<EpiG3, false, 1> E{EpiG3{p.ws, xc, xl, l, 2048}, p.ws, OFF_Z, 256 + l * 1024 + 512, ldsg, wb};
      pg8::gemm_phase<EpiSplit<EpiG3, false, 1>, pg8::StaticOrder, PG8_FLAGS>(ldsg, g, S, E, wb);
      if (l == 0 && blockIdx.x >= 128) { const int i0 = 640 + ((int)blockIdx.x - 128) * 8; deferred_convert(p, wb, i0, i0 + 8 < NJ_DEF ? i0 + 8 : NJ_DEF, lds); }
    }
    GRID_BAR();
    phase_ln<false, 4>(p, wb, (const float*)(WS(p) + OFF_Y), nullptr, nullptr, p.ln1_g + l * 1024, p.ln1_b + l * 1024, (const float*)(WS(p) + OFF_MOD) + l * 5 * 6144, 3072, 4096);
    GRID_BAR();
    {
      pg8::Gemm g{(const bf16_t*)(WS(p) + OFF_H), (const bf16_t*)(WS(p) + OFF_WF1 + l * SZ_WF), 1024, 1024};
      pg8::StaticOrder S; S.init(8192, 4096, (int)gridDim.x, (int)blockIdx.x, 16);
      EpiG4 E{p.ws, wb};
      pg8::gemm_phase<EpiG4, pg8::StaticOrder, PG8_FLAGS>(ldsg, g, S, E, wb);
    }
    GRID_BAR();
    {
      pg8::Gemm g{(const bf16_t*)(WS(p) + OFF_HID), (const bf16_t*)(WS(p) + OFF_WF2 + l * SZ_WF), 4096, 2048};
      SchedSplit2 S; S.so.init(8192, 1024, (int)gridDim.x, (int)blockIdx.x, 32); S.khalf_len = 2048; S.sn = 1;
      EpiSplit<EpiG5, false, 1> E{EpiG5{p.ws}, p.ws, OFF_Z, 256 + l * 1024 + 768, ldsg, wb};
      pg8::gemm_phase<EpiSplit<EpiG5, false, 1>, SchedSplit2, PG8_FLAGS>(ldsg, g, S, E, wb);
    }
    GRID_BAR();
    phase_ln<true, 4>(p, wb, (const float*)(WS(p) + OFF_Y), (const float*)(WS(p) + OFF_OA), (const float*)(WS(p) + OFF_MOD) + l * 5 * 6144 + 5120, p.ln2_g + l * 1024, p.ln2_b + l * 1024,
                   l == 0 ? (const float*)(WS(p) + OFF_MOD) + 5 * 6144 : nullptr, 0, 1024);
    GRID_BAR();
  }
}

extern "C" void kernel_launch(void* const* d_in, const int* in_sizes, int n_in, void* d_out, int out_size, void* d_ws, size_t ws_size, hipStream_t stream) {
  static int grid_blocks = 0;
  if (!grid_blocks) {
    int dev = 0, cus = 0, per_cu = 0;
    (void)hipGetDevice(&dev);
    (void)hipDeviceGetAttribute(&cus, hipDeviceAttributeMultiprocessorCount, dev);
    if (hipFuncSetAttribute((const void*)fwd_megakernel, hipFuncAttributeMaxDynamicSharedMemorySize, LDS_BYTES) != hipSuccess) fprintf(stderr, "hipFuncSetAttribute failed\n");
    (void)hipOccupancyMaxActiveBlocksPerMultiprocessor(&per_cu, fwd_megakernel, NTHR, LDS_BYTES);
    if (per_cu > 1) per_cu = 1;
    if (per_cu < 1) { fprintf(stderr, "occupancy query says 0 blocks per CU\n"); per_cu = 1; }
    grid_blocks = cus * per_cu;
  }
  if (ws_size < WS_NEED) { fprintf(stderr, "workspace too small: %zu < %zu\n", ws_size, (size_t)WS_NEED); return; }
  Params p{};
  const float** f = (const float**)&p;
  for (int i = 0; i < 29; ++i) f[i] = (const float*)d_in[i];
  p.out = (float*)d_out; p.ws = (char*)d_ws;
  p.lam_init[0] = (float)(0.8 - 0.6 * exp(-0.3 * 0.0));
  p.lam_init[1] = (float)(0.8 - 0.6 * exp(-0.3 * 1.0));
  (void)hipMemsetAsync((char*)d_ws + OFF_CNT, 0, OFF_YB - OFF_CNT, stream);
  void* args[] = {&p};
  hipError_t e = hipLaunchCooperativeKernel((void*)fwd_megakernel, dim3(grid_blocks), dim3(NTHR), args, LDS_BYTES, stream);
  if (e != hipSuccess) fprintf(stderr, "cooperative launch failed: %s (grid %d)\n", hipGetErrorString(e), grid_blocks);
}
```

```cpp
#include <hip/hip_runtime.h>
#include <hip/hip_cooperative_groups.h>
#include <cstdio>
#include <cstdint>
#include <cmath>
namespace cg = cooperative_groups;

typedef unsigned short bf16_t;
typedef short bf16x8 __attribute__((ext_vector_type(8)));
typedef float f32x4 __attribute__((ext_vector_type(4)));
typedef unsigned u32x4 __attribute__((ext_vector_type(4)));
typedef unsigned u32x2 __attribute__((ext_vector_type(2)));
typedef short s16x4 __attribute__((ext_vector_type(4)));
typedef __bf16 bf16x2_t __attribute__((ext_vector_type(2)));
typedef float f32x2_t __attribute__((ext_vector_type(2)));
typedef __attribute__((address_space(3))) s16x4* lds_s16x4_ptr;
#define LAS __attribute__((address_space(3)))

#define LOG2E 1.4426950408889634f
#define ALPHA_RES 1.4142135623730951f
#define LN_EPS 1e-5f

constexpr size_t SZ_WCAT = 6912ull * 1024 * 2, SZ_WP = 3ull * 1024 * 512 * 2, SZ_WO = 1024ull * 1024 * 2, SZ_WF = 4096ull * 1024 * 2;
constexpr size_t OFF_WCAT = 0;
constexpr size_t OFF_WP = OFF_WCAT + 2 * SZ_WCAT;
constexpr size_t OFF_WO = OFF_WP + 2 * SZ_WP;
constexpr size_t OFF_WF1 = OFF_WO + 2 * SZ_WO;
constexpr size_t OFF_WF2 = OFF_WF1 + 2 * SZ_WF;
constexpr size_t OFF_CDK = OFF_WF2 + 2 * SZ_WF;
constexpr size_t OFF_CDV = OFF_CDK + 2097152;
constexpr size_t OFF_CWK = OFF_CDV + 2097152;
constexpr size_t OFF_CWV = OFF_CWK + 524288;
constexpr size_t OFF_MOD = OFF_CWV + 524288;
constexpr size_t OFF_ROPE = OFF_MOD + 245760;
constexpr size_t OFF_H = OFF_ROPE + 8192;
constexpr size_t OFF_OA = OFF_H + 16777216;
constexpr size_t OFF_OB = OFF_OA + 8388608;
constexpr size_t OFF_OC = OFF_OB + 8388608;
constexpr size_t OFF_MRG = OFF_OC + 8388608;
constexpr size_t OFF_R = OFF_MRG + 16777216;
constexpr size_t OFF_Z = OFF_R;
constexpr size_t OFF_G = OFF_Z + 8192ull * 3840 * 2;
constexpr size_t OFF_HID = OFF_R;
constexpr size_t OFF_Y = OFF_R + 8192ull * 4096 * 2;
constexpr size_t OFF_CNT = OFF_G + 8192ull * 3072 * 2;
constexpr size_t OFF_BAR = OFF_CNT + 16384;
constexpr size_t OFF_YB = OFF_BAR + 3456 * 4 + 256;
constexpr size_t WS_NEED = OFF_YB + 8192ull * 512 * 4;
constexpr int NTHR = 512;
constexpr int LDS_BYTES = 131072 + 64;
constexpr int LDS_ST = 131072 + 16;
constexpr int LDS_FLAG = 131072;

constexpr size_t OUT_X = 0, OUT_DK = 8388608, OUT_DV = 12582912, OUT_WK = 16777216, OUT_WV = 17825792, OUT_ST = 18874368;

struct Params {
  const float *x_prompt, *x_sample, *c, *cache_diff_k, *cache_diff_v, *cache_win_k, *cache_win_v, *state_ret, *c_ctx;
  const float *w_mod, *b_mod, *w_in, *diff_lam, *diff_norm_g, *win_sink, *ret_decay, *ret_norm_g;
  const float *w_pa, *w_pb, *w_pc, *w_gate, *b_gate, *w_o, *ln1_g, *ln1_b, *w_ff1, *w_ff2, *ln2_g, *ln2_b;
  float* out;
  char* ws;
  float lam_init[2];
};

__device__ __forceinline__ unsigned cvtpk(float lo, float hi) { f32x2_t v = {lo, hi}; bf16x2_t b = __builtin_convertvector(v, bf16x2_t); return __builtin_bit_cast(unsigned, b); }
__device__ __forceinline__ bf16_t f2bf(float f) { return (bf16_t)(cvtpk(f, 0.f) & 0xffffu); }
__device__ __forceinline__ float bf2f(unsigned short b) { return __uint_as_float(((unsigned)b) << 16); }
__device__ __forceinline__ float bflo(unsigned u) { return __uint_as_float(u << 16); }
__device__ __forceinline__ float bfhi(unsigned u) { return __uint_as_float(u & 0xffff0000u); }
__device__ __forceinline__ u32x2 pack4(f32x4 v) { u32x2 r; r.x = cvtpk(v[0], v[1]); r.y = cvtpk(v[2], v[3]); return r; }
__device__ __forceinline__ f32x4 unpack4(u32x2 u) { f32x4 r; r[0] = bflo(u.x); r[1] = bfhi(u.x); r[2] = bflo(u.y); r[3] = bfhi(u.y); return r; }
__device__ __forceinline__ s16x4 vtr(const char* p) { return __builtin_amdgcn_ds_read_tr16_b64_v4i16((lds_s16x4_ptr)(p)); }
__device__ __forceinline__ bf16x8 cat8(s16x4 lo, s16x4 hi) { return (bf16x8){lo[0], lo[1], lo[2], lo[3], hi[0], hi[1], hi[2], hi[3]}; }
__device__ __forceinline__ f32x4 mfma16(bf16x8 a, bf16x8 b, f32x4 c) { return __builtin_amdgcn_mfma_f32_16x16x32_bf16(a, b, c, 0, 0, 0); }
__device__ __forceinline__ float quad_sum(float v) { v += __shfl_xor(v, 16); v += __shfl_xor(v, 32); return v; }
__device__ __forceinline__ float quad_max(float v) { v = fmaxf(v, __shfl_xor(v, 16)); v = fmaxf(v, __shfl_xor(v, 32)); return v; }
__device__ __forceinline__ float wave_sum(float v) {
#pragma unroll
  for (int o = 32; o > 0; o >>= 1) v += __shfl_xor(v, o);
  return v;
}
__device__ __forceinline__ int lane_id() { return (int)__builtin_amdgcn_mbcnt_hi(~0u, __builtin_amdgcn_mbcnt_lo(~0u, 0u)); }
__device__ __forceinline__ int ozero() { int z; asm volatile("s_mov_b32 %0, 0" : "=s"(z)); return z; }
__device__ __forceinline__ int otid_w(int wbase) { asm volatile("" : "+s"(wbase)); return wbase | lane_id(); }
#define otid() otid_w(wb)
__device__ __forceinline__ char* opq(char* w) { return (char*)((uintptr_t)w ^ (uintptr_t)(unsigned)ozero()); }
__device__ __forceinline__ float* opqf(float* w) { return (float*)((uintptr_t)w ^ (uintptr_t)(unsigned)ozero()); }
__device__ __forceinline__ int row_group(int row) { return row < 4096 ? 0 : 1 + ((row - 4096) >> 10); }

#define WS(p) opq((p).ws)
#define OUTP(p) opqf((p).out)

namespace pg8 {
#define PG8_LAS __attribute__((address_space(3)))
constexpr int BM = 256, BK = 64, HALF = 128, HTB = HALF * BK * 2  , STAGE_BYTES = 8 * HTB, NXCD = 8, WGM = 8;

__host__ __device__ __forceinline__ int lds_byte(int r, int c) { const int st = (r >> 4) * 2 + (c >> 5), rr = r & 15, cc = c & 31, ob = rr * 64 + cc * 2; return st * 1024 + (ob ^ (((ob >> 9) & 1) << 5)); }
__host__ __device__ __forceinline__ void stage_rc(int b, int& R, int& C) { const int st = b / 1024, sb = b % 1024, swz = sb ^ (((sb >> 9) & 1) << 5); R = (st >> 1) * 16 + swz / 64; C = (st & 1) * 32 + (swz % 64) / 2; }
__host__ __device__ __forceinline__ int perm32(int rho) { const int n = rho >> 4, i = rho & 15; return 8 * (i >> 2) + 4 * n + (i & 3); }

struct Unit { int pm, pn, ko, sn, slot; };
struct Gemm { const bf16_t* A; const bf16_t* Bt; int ld, K; };

struct StaticOrder {
    int nM, nN, nwg, G, c, kt;
    __host__ __device__ __forceinline__ void init(int M, int N, int G_, int c_, int kt_) { nM = M / BM; nN = N / BM; nwg = nM * nN; G = G_; c = c_; kt = kt_; }
    __host__ __device__ __forceinline__ bool next(int i, Unit& u) const { return at((long)i * G + c, u); }
    __host__ __device__ __forceinline__ bool at(long L, Unit& u) const {
        if (L >= nwg) return false;
        int wgid = (int)L; { const int q = nwg / NXCD, r = nwg % NXCD, xcd = wgid % NXCD, off = wgid / NXCD; wgid = (xcd < r ? xcd * (q + 1) : r * (q + 1) + (xcd - r) * q) + off; }
        const int nig = WGM * nN, gid = wgid / nig, fm = gid * WGM, gsz = (nM - fm) < WGM ? (nM - fm) : WGM;
        u.pm = fm + ((wgid % nig) % gsz); u.pn = (wgid % nig) / gsz; u.ko = 0; u.sn = 1; u.slot = 0; return true;
    }
    __device__ __forceinline__ void a_ready(const Unit&) const {}
    __device__ __forceinline__ void done(const Unit&) const {}
};


template <class Epi, class Sched, bool ALIGN_EPI = false, bool SP2 = false>
__device__ __forceinline__ void gemm_phase(PG8_LAS unsigned char* lds, const Gemm g, const Sched& S, const Epi& E, int wbase) {
    const int tid = otid_w(wbase), wid = __builtin_amdgcn_readfirstlane(tid >> 6), lane = tid & 63, wr = wid >> 2, wc = wid & 3, fr = lane & 15, fq = lane >> 4;
    const int K = g.ld, nt = g.K / BK;
    unsigned voffA[2], voffB[2];
#pragma unroll
    for (int i = 0; i < 2; ++i) { int R, C; stage_rc(tid * 16 + i * 8192, R, C); const int Rb = Epi::PERM ? ((R & ~31) + perm32(R & 31)) : R;
        voffA[i] = (unsigned)(R * K + C) * 2u; voffB[i] = (unsigned)(Rb * K + C) * 2u; }
    const size_t kstep = (size_t)(BK * 2);
    const size_t hstep = (size_t)HALF * K * 2;
    const size_t tstep = 2 * hstep;
    const unsigned ldsw = (unsigned)wid * 1024u;
    const int aoff = lds_byte(wr * 64 + fr, fq * 8), boff = lds_byte(wc * 32 + fr, fq * 8);
#define PG8_SA(b, h) (((b) * 2 + (h)) * HTB)
#define PG8_SB(b, h) ((4 + (b) * 2 + (h)) * HTB)
#define PG8_STAGE(bufoff, gbase, voff) do { _Pragma("unroll") for (int _i = 0; _i < 2; ++_i) \
        __builtin_amdgcn_global_load_lds((const unsigned*)((const char*)(gbase) + (voff)[_i]), (PG8_LAS unsigned*)(lds + (bufoff) + ldsw + _i * 8192), 16, 0, 0); } while (0)
#define PG8_LDA(dst, b, h) do { _Pragma("unroll") for (int m = 0; m < 4; ++m) _Pragma("unroll") for (int k = 0; k < 2; ++k) dst[m][k] = *(const PG8_LAS bf16x8*)(lds + PG8_SA(b, h) + aoff + m * 2048 + k * 1024); } while (0)
#define PG8_LDB(dst, b, h) do { _Pragma("unroll") for (int n = 0; n < 2; ++n) _Pragma("unroll") for (int k = 0; k < 2; ++k) dst[n][k] = *(const PG8_LAS bf16x8*)(lds + PG8_SB(b, h) + boff + n * 2048 + k * 1024); } while (0)
#define PG8_MMA(ai, bj, At, Bt) do { __builtin_amdgcn_s_setprio(1); _Pragma("unroll") for (int m = 0; m < 4; ++m) _Pragma("unroll") for (int n = 0; n < 2; ++n) _Pragma("unroll") for (int k = 0; k < 2; ++k) \
        acc[ai][bj][m][n] = __builtin_amdgcn_mfma_f32_16x16x32_bf16(Bt[n][k], At[m][k], acc[ai][bj][m][n], 0, 0, 0); __builtin_amdgcn_s_setprio(0); } while (0)
#define PG8_WAIT_V(n) asm volatile("s_waitcnt vmcnt(" #n ")" ::: "memory")
#define PG8_WAIT_L(n) asm volatile("s_waitcnt lgkmcnt(" #n ")" ::: "memory")
#define PG8_BAR __builtin_amdgcn_s_barrier()
#define PG8_SCHED __builtin_amdgcn_sched_barrier(0)
    Unit cur, nxt; int ui = 0;
    if (!S.next(0, cur)) return;
    f32x4 acc[2][2][4][2];
#pragma unroll
    for (int a = 0; a < 2; ++a)
#pragma unroll
        for (int b = 0; b < 2; ++b)
#pragma unroll
            for (int m = 0; m < 4; ++m)
#pragma unroll
                for (int n = 0; n < 2; ++n) acc[a][b][m][n] = (f32x4){0.f, 0.f, 0.f, 0.f};
    bf16x8 At[4][2], B0[2][2], B1[2][2];
    const char* cA = (const char*)g.A + (size_t)cur.pm * tstep + (size_t)cur.ko * 2; const char* cB = (const char*)g.Bt + (size_t)cur.pn * tstep + (size_t)cur.ko * 2;
    S.a_ready(cur);
    if constexpr (SP2) {
        PG8_STAGE(PG8_SB(0, 0), cB, voffB); PG8_STAGE(PG8_SB(0, 1), cB + hstep, voffB); PG8_STAGE(PG8_SA(0, 0), cA, voffA); PG8_STAGE(PG8_SA(0, 1), cA + hstep, voffA);
        if (wr == 1) PG8_BAR;
        PG8_WAIT_V(2); PG8_BAR;
        PG8_STAGE(PG8_SB(1, 0), cB + kstep, voffB); PG8_STAGE(PG8_SA(1, 0), cA + kstep, voffA); PG8_STAGE(PG8_SB(1, 1), cB + hstep + kstep, voffB);
        PG8_WAIT_V(6); PG8_BAR;
    } else {
        PG8_STAGE(PG8_SB(0, 0), cB, voffB); PG8_STAGE(PG8_SA(0, 0), cA, voffA); PG8_STAGE(PG8_SB(0, 1), cB + hstep, voffB); PG8_STAGE(PG8_SA(0, 1), cA + hstep, voffA);
        if (wr == 1) PG8_BAR;
        PG8_WAIT_V(4); PG8_BAR;
        PG8_STAGE(PG8_SB(1, 0), cB + kstep, voffB); PG8_STAGE(PG8_SA(1, 0), cA + kstep, voffA); PG8_STAGE(PG8_SB(1, 1), cB + hstep + kstep, voffB);
        PG8_WAIT_V(6); PG8_BAR;
    }
    for (;;) {
        const bool has_next = S.next(ui + 1, nxt);
        const char* nA = has_next ? (const char*)g.A + (size_t)nxt.pm * tstep + (size_t)nxt.ko * 2 : cA; const char* nB = has_next ? (const char*)g.Bt + (size_t)nxt.pn * tstep + (size_t)nxt.ko * 2 : cB;
        const int nt_u = cur.sn == 2 ? (nt >> 1) : nt;
        for (int t = 0; t < nt_u; t += 2) {
            const bool last = (t == nt_u - 2);
            const char* a1 = cA + (size_t)(t + 1) * kstep;
            const char* a2 = last ? nA : cA + (size_t)(t + 2) * kstep; const char* b2 = last ? nB : cB + (size_t)(t + 2) * kstep;
            const char* a3 = a2 + kstep; const char* b3 = b2 + kstep;
            if (last && has_next) S.a_ready(nxt);
            if constexpr (SP2) {
            PG8_LDB(B0, 0, 0); PG8_LDB(B1, 0, 1); PG8_SCHED; PG8_LDA(At, 0, 0); PG8_STAGE(PG8_SA(1, 1), a1 + hstep, voffA);
            PG8_WAIT_V(8); PG8_WAIT_L(0); PG8_BAR; PG8_MMA(0, 0, At, B0); PG8_MMA(0, 1, At, B1); PG8_BAR; PG8_SCHED;
            PG8_LDA(At, 0, 1); PG8_STAGE(PG8_SB(0, 0), b2, voffB); PG8_STAGE(PG8_SB(0, 1), b2 + hstep, voffB); PG8_STAGE(PG8_SA(0, 0), a2, voffA);
            PG8_WAIT_V(8); PG8_WAIT_L(0); PG8_BAR; PG8_MMA(1, 0, At, B0); PG8_MMA(1, 1, At, B1); PG8_BAR; PG8_SCHED;
            PG8_LDB(B0, 1, 0); PG8_LDB(B1, 1, 1); PG8_SCHED; PG8_LDA(At, 1, 0); PG8_STAGE(PG8_SA(0, 1), a2 + hstep, voffA);
            PG8_WAIT_V(8); PG8_WAIT_L(0); PG8_BAR; PG8_MMA(0, 0, At, B0); PG8_MMA(0, 1, At, B1); PG8_BAR; PG8_SCHED;
            PG8_LDA(At, 1, 1); PG8_STAGE(PG8_SB(1, 0), b3, voffB); PG8_STAGE(PG8_SB(1, 1), b3 + hstep, voffB); PG8_STAGE(PG8_SA(1, 0), a3, voffA);
            PG8_WAIT_V(8); PG8_WAIT_L(0); PG8_BAR; PG8_MMA(1, 0, At, B0); PG8_MMA(1, 1, At, B1); PG8_BAR; PG8_SCHED;
            } else {
            PG8_LDB(B0, 0, 0); PG8_SCHED; PG8_LDA(At, 0, 0); PG8_STAGE(PG8_SA(1, 1), a1 + hstep, voffA);
            PG8_WAIT_L(8); PG8_BAR; PG8_WAIT_L(0); PG8_MMA(0, 0, At, B0); PG8_BAR; PG8_SCHED;
            PG8_LDB(B1, 0, 1); PG8_STAGE(PG8_SB(0, 0), b2, voffB);
            PG8_BAR; PG8_WAIT_L(0); PG8_MMA(0, 1, At, B1); PG8_BAR;
            PG8_LDA(At, 0, 1); PG8_STAGE(PG8_SA(0, 0), a2, voffA);
            PG8_BAR; PG8_WAIT_L(0); PG8_MMA(1, 0, At, B0); PG8_BAR; PG8_SCHED;
            PG8_STAGE(PG8_SB(0, 1), b2 + hstep, voffB);
            PG8_WAIT_V(6); PG8_BAR; PG8_MMA(1, 1, At, B1); PG8_BAR;
            PG8_LDB(B0, 1, 0); PG8_SCHED; PG8_LDA(At, 1, 0); PG8_STAGE(PG8_SA(0, 1), a2 + hstep, voffA);
            PG8_WAIT_L(8); PG8_BAR; PG8_WAIT_L(0); PG8_MMA(0, 0, At, B0); PG8_BAR; PG8_SCHED;
            PG8_LDB(B1, 1, 1); PG8_STAGE(PG8_SB(1, 0), b3, voffB);
            PG8_BAR; PG8_WAIT_L(0); PG8_MMA(0, 1, At, B1); PG8_BAR;
            PG8_LDA(At, 1, 1); PG8_STAGE(PG8_SA(1, 0), a3, voffA);
            PG8_BAR; PG8_WAIT_L(0); PG8_MMA(1, 0, At, B0); PG8_BAR; PG8_SCHED;
            PG8_STAGE(PG8_SB(1, 1), b3 + hstep, voffB);
            PG8_WAIT_V(6); PG8_BAR; PG8_MMA(1, 1, At, B1); PG8_BAR;
            }
        }
        if constexpr (ALIGN_EPI) { if (wr == 0) PG8_BAR; }
        if constexpr (!Epi::AFTER_DRAIN) { E(acc, cur, wr, wc, fr, fq); S.done(cur); }
        if (!has_next) break;
#pragma unroll
        for (int a = 0; a < 2; ++a)
#pragma unroll
            for (int b = 0; b < 2; ++b)
#pragma unroll
                for (int m = 0; m < 4; ++m)
#pragma unroll
                    for (int n = 0; n < 2; ++n) acc[a][b][m][n] = (f32x4){0.f, 0.f, 0.f, 0.f};
        cur = nxt; cA = nA; cB = nB; ++ui;
        if constexpr (ALIGN_EPI) { if (wr == 1) PG8_BAR; }
    }
    PG8_WAIT_V(0);
    if constexpr (!ALIGN_EPI) { if (wr == 0) PG8_BAR; }
    PG8_BAR;
    if constexpr (Epi::AFTER_DRAIN) { E.fused(acc, cur, wr, wc, fr, fq, lds, wid, lane); S.done(cur); }
#undef PG8_SA
#undef PG8_SB
#undef PG8_STAGE
#undef PG8_LDA
#undef PG8_LDB
#undef PG8_MMA
#undef PG8_WAIT_V
#undef PG8_WAIT_L
#undef PG8_BAR
#undef PG8_SCHED
}
}

typedef f32x4 AccT[2][2][4][2];
struct SchedG1 {
  pg8::StaticOrder sz, sg;
  __device__ __forceinline__ bool at(int L, pg8::Unit& u) const {
    if (L < 480) return sz.at(L, u);
    if (!sg.at(L - 480, u)) return false;
    u.pn += 15; return true;
  }
  __device__ __forceinline__ bool next(int i, pg8::Unit& u) const { return i < 3 && at(i * 256 + sz.c, u); }
  __device__ __forceinline__ void a_ready(const pg8::Unit&) const {}
  __device__ __forceinline__ void done(const pg8::Unit&) const {}
};
struct SchedOne {
  pg8::Unit u0;
  __device__ __forceinline__ bool next(int i, pg8::Unit& u) const { if (i > 0) return false; u = u0; return true; }
  __device__ __forceinline__ void a_ready(const pg8::Unit&) const {}
  __device__ __forceinline__ void done(const pg8::Unit&) const {}
};
struct SchedBr {
  pg8::StaticOrder so;
  __device__ __forceinline__ bool next(int i, pg8::Unit& u) const {
    if (i > 1 || (i == 1 && so.c >= 128)) return false;
    const int t = so.c & 127, br = i == 0 ? (so.c >> 7) : 2;
    so.at(t, u); u.pm += br * 32; u.pn += br * 4; u.sn = 3; u.slot = t; return true;
  }
  __device__ __forceinline__ void a_ready(const pg8::Unit&) const {}
  __device__ __forceinline__ void done(const pg8::Unit&) const {}
};
struct SchedSplit2 {
  pg8::StaticOrder so; int khalf_len, sn;
  __device__ __forceinline__ bool next(int i, pg8::Unit& u) const {
    if (i >= 1) return false;
    const int t = so.c & 127;
    so.at(t, u); u.ko = (so.c >> 7) * khalf_len; u.sn = sn; u.slot = t; return true;
  }
  __device__ __forceinline__ void a_ready(const pg8::Unit&) const {}
  __device__ __forceinline__ void done(const pg8::Unit&) const {}
};
struct PartRef { __amdgpu_buffer_rsrc_t rs; int voff; };
template <bool BF16P> __device__ __forceinline__ f32x4 part_ld(const PartRef& pr, int soff) {
  if (BF16P) return unpack4(__builtin_bit_cast(u32x2, __builtin_amdgcn_raw_buffer_load_b64(pr.rs, pr.voff, soff, 0)));
  return __builtin_bit_cast(f32x4, __builtin_amdgcn_raw_buffer_load_b128(pr.rs, pr.voff, soff, 0));
}
template <int NP, bool BF16P> __device__ __forceinline__ f32x4 accv(const AccT& acc, int ai, int bj, int m, int n, const PartRef& pr) {
  constexpr int PB = BF16P ? 8 : 16, IMG = 16384 * PB;
  const int q = ai * 16 + bj * 8 + m * 2 + n;
  f32x4 v = acc[ai][bj][m][n];
  if (NP >= 1) v += part_ld<BF16P>(pr, q * 512 * PB);
  if (NP >= 2) v += part_ld<BF16P>(pr, IMG + q * 512 * PB);
  return v;
}
template <class Inner, bool BF16P, int NPC>
struct EpiSplit {
  static constexpr bool PERM = Inner::PERM, AFTER_DRAIN = false;
  Inner in; char* ws; size_t part_off; int cnt_base; LAS unsigned char* ldsp; int wbase;
  __device__ __forceinline__ void operator()(AccT& acc, const pg8::Unit& u, int, int, int, int) const {
    int lane_ = lane_id(), wv_ = wbase; asm volatile("" : "+v"(lane_), "+s"(wv_));
    const int fr = lane_ & 15, fq = lane_ >> 4, wr = wv_ >> 8, wc = (wv_ >> 6) & 3;
    in.pre(acc, u, wr, wc, fr, fq);
    constexpr int PB = BF16P ? 8 : 16, IMG = 16384 * PB;
    if (u.sn == 1) { const PartRef pr0{__builtin_amdgcn_make_buffer_rsrc((void*)ws, (short)0, 0, 0x00020000), 0}; in.template fin<0, BF16P>(acc, u, wr, wc, fr, fq, pr0); return; }
    const int tid = wv_ + lane_;
    char* w_ = opq(ws);
    unsigned* c = (unsigned*)(w_ + OFF_CNT) + cnt_base + u.slot * 2;
    LAS int* role = (LAS int*)(ldsp + LDS_FLAG);
    if (tid == 0) { *role = (int)__hip_atomic_fetch_add(c, 1u, __ATOMIC_RELAXED, __HIP_MEMORY_SCOPE_AGENT); asm volatile("s_waitcnt lgkmcnt(0)" ::: "memory"); }
    __builtin_amdgcn_s_barrier(); asm volatile("" ::: "memory");
    const int r = __builtin_amdgcn_readfirstlane(*role);
    if (r < NPC) {
      const __amdgpu_buffer_rsrc_t rs = __builtin_amdgcn_make_buffer_rsrc((void*)(w_ + part_off + (size_t)(u.slot * NPC + r) * IMG), (short)0, IMG, 0x00020000);
#pragma unroll
      for (int q = 0; q < 32; ++q) {
        if (BF16P) { typedef unsigned v2u_ __attribute__((__vector_size__(2 * sizeof(unsigned)))); const u32x2 t_ = pack4(acc[q >> 4][(q >> 3) & 1][(q >> 1) & 3][q & 1]); __builtin_amdgcn_raw_buffer_store_b64(__builtin_bit_cast(v2u_, t_), rs, tid * PB, q * 512 * PB, 0); }
        else __builtin_amdgcn_raw_buffer_store_b128(__builtin_bit_cast(u32x4, acc[q >> 4][(q >> 3) & 1][(q >> 1) & 3][q & 1]), rs, tid * PB, q * 512 * PB, 0);
      }
      asm volatile("s_waitcnt vmcnt(0)" ::: "memory");
      __builtin_amdgcn_s_barrier(); asm volatile("" ::: "memory");
      if (tid == 0) {
        __builtin_amdgcn_fence(__ATOMIC_RELEASE, "agent");
        asm volatile("s_waitcnt vmcnt(0)" ::: "memory");
        (void)__hip_atomic_fetch_add(c + 1, 1u, __ATOMIC_RELAXED, __HIP_MEMORY_SCOPE_AGENT);
      }
      return;
    }
    if (tid == 0) {
      unsigned sp = 0;
      while (__hip_atomic_load(c + 1, __ATOMIC_RELAXED, __HIP_MEMORY_SCOPE_AGENT) < (unsigned)NPC) { __builtin_amdgcn_s_sleep(1); if (++sp > (1u << 22)) break; }
      __builtin_amdgcn_fence(__ATOMIC_ACQUIRE, "agent");
      asm volatile("s_waitcnt vmcnt(0)" ::: "memory");
    }
    __builtin_amdgcn_s_barrier(); asm volatile("" ::: "memory");
    const PartRef prc{__builtin_amdgcn_make_buffer_rsrc((void*)(w_ + part_off + (size_t)(u.slot * NPC) * IMG), (short)0, NPC * IMG, 0x00020000), tid * PB};
    in.template fin<NPC, BF16P>(acc, u, wr, wc, fr, fq, prc);
  }
};
struct EpiG1 {
  static constexpr bool PERM = true, AFTER_DRAIN = false;
  __device__ __forceinline__ void pre(AccT&, const pg8::Unit&, int, int, int, int) const {}
  char* ws; const float* b_gate; float* out_; int l;
  template <int NP, bool BF16P> __device__ __forceinline__ void fin(const AccT& acc, const pg8::Unit& u, int wr, int wc, int fr, int fq, const PartRef& pb) const {
    char* w_ = opq(ws); float* out = opqf(out_);
    bf16_t* Z = (bf16_t*)(w_ + OFF_Z); bf16_t* G = (bf16_t*)(w_ + OFF_G); const float* cosT = (const float*)(w_ + OFF_ROPE); const float* sinT = cosT + 1024;
    const bool lat = u.pm >= 16;
    const bool lo = fq < 2;
    const int fi = (fq & 1) * 8;
#pragma unroll
    for (int bj = 0; bj < 2; ++bj) {
      const int colg = u.pn * 256 + bj * 128 + wc * 32;
      if (colg < 3840) {
        const bool rope = lat && (colg < 1024 || (colg >= 1536 && colg < 2176));
        const bool second = (colg & 32) != 0;
        const float scl = (colg < 512 || (colg >= 1536 && colg < 2048) || (colg >= 2560 && colg < 2816)) ? 0.125f : 1.f;
        float* outp = nullptr; int outld = 0, outc = 0;
        if (!lat) {
          if (colg >= 512 && colg < 1024) { outp = out + OUT_DK; outld = 512; outc = colg - 512; }
          else if (colg >= 1024 && colg < 1536) { outp = out + OUT_DV; outld = 512; outc = colg - 1024; }
          else if (colg >= 2048 && colg < 2176) { outp = out + OUT_WK; outld = 128; outc = colg - 2048; }
          else if (colg >= 2176 && colg < 2304) { outp = out + OUT_WV; outld = 128; outc = colg - 2176; }
        }
#pragma unroll
        for (int ai = 0; ai < 2; ++ai)
#pragma unroll
          for (int m = 0; m < 4; ++m) {
            const int row = u.pm * 256 + ai * 128 + wr * 64 + m * 16 + fr;
            f32x4 v0 = accv<NP, BF16P>(acc, ai, bj, m, 0, pb), v1 = accv<NP, BF16P>(acc, ai, bj, m, 1, pb);
            if (rope) {
              const int t = (row - 4096) & 1023, pos = second ? (t & 63) : (t >> 6);
              const f32x4 ca = *(const f32x4*)(cosT + pos * 16 + fi), cb = *(const f32x4*)(cosT + pos * 16 + fi + 4);
              const f32x4 sa = *(const f32x4*)(sinT + pos * 16 + fi), sb = *(const f32x4*)(sinT + pos * 16 + fi + 4);
#pragma unroll
              for (int j = 0; j < 4; ++j) {
                const float p0 = __shfl_xor(v0[j], 32), p1 = __shfl_xor(v1[j], 32);
                v0[j] = lo ? v0[j] * ca[j] - p0 * sa[j] : p0 * sa[j] + v0[j] * ca[j];
                v1[j] = lo ? v1[j] * cb[j] - p1 * sb[j] : p1 * sb[j] + v1[j] * cb[j];
              }
            }
            if (outp) {
              float* op = outp + (size_t)(((row >> 8) * 2 + l) * 256 + (row & 255)) * outld + outc + fq * 8;
              *(f32x4*)op = v0; *(f32x4*)(op + 4) = v1;
            }
            const u32x2 a0 = pack4(v0 * scl), a1 = pack4(v1 * scl);
            *(u32x4*)(Z + (size_t)row * 3840 + colg + fq * 8) = (u32x4){a0.x, a0.y, a1.x, a1.y};
          }
      } else {
        const int gc = colg - 3840;
        const f32x4 b0 = *(const f32x4*)(b_gate + l * 3072 + gc + fq * 8), b1 = *(const f32x4*)(b_gate + l * 3072 + gc + fq * 8 + 4);
#pragma unroll
        for (int ai = 0; ai < 2; ++ai)
#pragma unroll
          for (int m = 0; m < 4; ++m) {
            const int row = u.pm * 256 + ai * 128 + wr * 64 + m * 16 + fr;
            f32x4 v0 = accv<NP, BF16P>(acc, ai, bj, m, 0, pb) + b0, v1 = accv<NP, BF16P>(acc, ai, bj, m, 1, pb) + b1;
#pragma unroll
            for (int j = 0; j < 4; ++j) { v0[j] = __builtin_amdgcn_rcpf(1.f + __expf(-v0[j])); v1[j] = __builtin_amdgcn_rcpf(1.f + __expf(-v1[j])); }
            const u32x2 a0 = pack4(v0), a1 = pack4(v1);
            *(u32x4*)(G + (size_t)row * 3072 + gc + fq * 8) = (u32x4){a0.x, a0.y, a1.x, a1.y};
          }
      }
    }
  }
};
struct EpiG2 {
  static constexpr bool PERM = true, AFTER_DRAIN = false;
  char* ws;
  __device__ __forceinline__ void pre(AccT& acc, const pg8::Unit& u, int wr, int wc, int fr, int fq) const {
    const bf16_t* G = (const bf16_t*)(opq(ws) + OFF_G);
    const int br = u.pm >> 5, pm = u.pm & 31, pn = u.pn & 3;
#pragma unroll
    for (int ai = 0; ai < 2; ++ai)
#pragma unroll
      for (int m = 0; m < 4; ++m) {
        const int row = pm * 256 + ai * 128 + wr * 64 + m * 16 + fr;
#pragma unroll
        for (int bj = 0; bj < 2; ++bj) {
          const int col = pn * 256 + bj * 128 + wc * 32 + fq * 8;
          const u32x4 g = *(const u32x4*)(G + (size_t)row * 3072 + br * 1024 + col);
          acc[ai][bj][m][0] *= unpack4((u32x2){g.x, g.y});
          acc[ai][bj][m][1] *= unpack4((u32x2){g.z, g.w});
        }
        asm volatile("" ::: "memory");
      }
  }
  template <int NP, bool BF16P> __device__ __forceinline__ void fin(const AccT& acc, const pg8::Unit& u, int wr, int wc, int fr, int fq, const PartRef& pb) const {
    bf16_t* MRG = (bf16_t*)(opq(ws) + OFF_MRG);
    const int pm = u.pm & 31, pn = u.pn & 3;
#pragma unroll
    for (int ai = 0; ai < 2; ++ai)
#pragma unroll
      for (int m = 0; m < 4; ++m) {
        const int row = pm * 256 + ai * 128 + wr * 64 + m * 16 + fr;
#pragma unroll
        for (int bj = 0; bj < 2; ++bj) {
          const int col = pn * 256 + bj * 128 + wc * 32 + fq * 8;
          const u32x2 a0 = pack4(accv<NP, BF16P>(acc, ai, bj, m, 0, pb)), a1 = pack4(accv<NP, BF16P>(acc, ai, bj, m, 1, pb));
          *(u32x4*)(MRG + (size_t)row * 1024 + col) = (u32x4){a0.x, a0.y, a1.x, a1.y};
        }
      }
  }
};
struct EpiG3 {
  static constexpr bool PERM = true, AFTER_DRAIN = false;
  char* ws; const float* xc_; const float* xl_; int l, goff;
  __device__ __forceinline__ void pre(AccT&, const pg8::Unit&, int, int, int, int) const {}
  template <int NP, bool BF16P> __device__ __forceinline__ void fin(const AccT& acc, const pg8::Unit& u, int wr, int wc, int fr, int fq, const PartRef& pb) const {
    char* w_ = opq(ws);
    const float* xc = opqf((float*)xc_); const float* xl = opqf((float*)xl_);
    const float* mod = (const float*)(w_ + OFF_MOD) + l * 5 * 6144 + goff; bf16_t* Y = (bf16_t*)(w_ + OFF_Y);
#pragma unroll
    for (int ai = 0; ai < 2; ++ai)
#pragma unroll
      for (int m = 0; m < 4; ++m) {
        const int row = u.pm * 256 + ai * 128 + wr * 64 + m * 16 + fr;
        const float* xp = row < 4096 ? xc + (size_t)row * 1024 : xl + (size_t)(row - 4096) * 1024;
        const float* gp = mod + row_group(row) * 6144;
#pragma unroll
        for (int bj = 0; bj < 2; ++bj) {
          const int col = u.pn * 256 + bj * 128 + wc * 32 + fq * 8;
          const u32x2 a0 = pack4(*(const f32x4*)(xp + col) * ALPHA_RES + *(const f32x4*)(gp + col) * accv<NP, BF16P>(acc, ai, bj, m, 0, pb));
          const u32x2 a1 = pack4(*(const f32x4*)(xp + col + 4) * ALPHA_RES + *(const f32x4*)(gp + col + 4) * accv<NP, BF16P>(acc, ai, bj, m, 1, pb));
          *(u32x4*)(Y + (size_t)row * 1024 + col) = (u32x4){a0.x, a0.y, a1.x, a1.y};
        }
      }
  }
};
struct EpiG5 {
  static constexpr bool PERM = true, AFTER_DRAIN = false;
  char* ws;
  __device__ __forceinline__ void pre(AccT&, const pg8::Unit&, int, int, int, int) const {}
  template <int NP, bool BF16P> __device__ __forceinline__ void fin(const AccT& acc, const pg8::Unit& u, int wr, int wc, int fr, int fq, const PartRef&) const {
    bf16_t* P = (bf16_t*)(opq(ws) + (u.ko ? OFF_OA : OFF_Y));
#pragma unroll
    for (int ai = 0; ai < 2; ++ai)
#pragma unroll
      for (int m = 0; m < 4; ++m) {
        const int row = u.pm * 256 + ai * 128 + wr * 64 + m * 16 + fr;
#pragma unroll
        for (int bj = 0; bj < 2; ++bj) {
          const int col = u.pn * 256 + bj * 128 + wc * 32 + fq * 8;
          const u32x2 a0 = pack4(acc[ai][bj][m][0]), a1 = pack4(acc[ai][bj][m][1]);
          *(u32x4*)(P + (size_t)row * 1024 + col) = (u32x4){a0.x, a0.y, a1.x, a1.y};
        }
      }
  }
};
struct EpiG4 {
  static constexpr bool PERM = true, AFTER_DRAIN = false;
  char* ws; int wbase;
  __device__ __forceinline__ void operator()(const AccT& acc, const pg8::Unit& u, int, int, int, int) const {
    int lane_ = lane_id(), wv_ = wbase; asm volatile("" : "+v"(lane_), "+s"(wv_));
    const int fr = lane_ & 15, fq = lane_ >> 4, wr = wv_ >> 8, wc = (wv_ >> 6) & 3;
    bf16_t* HID = (bf16_t*)(opq(ws) + OFF_HID);
#pragma unroll
    for (int ai = 0; ai < 2; ++ai)
#pragma unroll
      for (int m = 0; m < 4; ++m) {
        const int row = u.pm * 256 + ai * 128 + wr * 64 + m * 16 + fr;
#pragma unroll
        for (int bj = 0; bj < 2; ++bj) {
          const int col = u.pn * 256 + bj * 128 + wc * 32 + fq * 8;
          f32x4 v0 = acc[ai][bj][m][0], v1 = acc[ai][bj][m][1];
#pragma unroll
          for (int j = 0; j < 4; ++j) { const float r0 = fmaxf(v0[j], 0.f), r1 = fmaxf(v1[j], 0.f); v0[j] = r0 * r0; v1[j] = r1 * r1; }
          const u32x2 a0 = pack4(v0), a1 = pack4(v1);
          *(u32x4*)(HID + (size_t)row * 4096 + col) = (u32x4){a0.x, a0.y, a1.x, a1.y};
        }
      }
  }
};

__device__ void job_mod(const Params& p, int wb, int j, char* lds) {
  const int tid = otid();
  const int l = j / 96, chunk = j % 96;
  float* sil = (float*)lds;
  float* red = (float*)(lds + 20480);
  for (int i = tid; i < 5 * 1024; i += NTHR) {
    const int g = i >> 10, k = i & 1023;
    const float cv = (g == 0) ? p.c_ctx[k] : p.c[(g - 1) * 1024 + k];
    sil[i] = cv / (1.f + expf(-cv));
  }
  __syncthreads();
  const int cg4 = tid & 15, kg = tid >> 4;
  f32x4 acc[5];
#pragma unroll
  for (int g = 0; g < 5; ++g) acc[g] = (f32x4){0.f, 0.f, 0.f, 0.f};
  const float* w = p.w_mod + (size_t)l * 1024 * 6144 + chunk * 64 + cg4 * 4;
#pragma unroll 1
  for (int k0 = 0; k0 < 32; k0 += 8) {
    f32x4 wv[8];
#pragma unroll
    for (int e = 0; e < 8; ++e) wv[e] = *(const f32x4*)(w + (size_t)(kg * 32 + k0 + e) * 6144);
#pragma unroll
    for (int e = 0; e < 8; ++e)
#pragma unroll
      for (int g = 0; g < 5; ++g) acc[g] += wv[e] * sil[g * 1024 + kg * 32 + k0 + e];
  }
#pragma unroll
  for (int g = 0; g < 5; ++g) *(f32x4*)(red + (kg * 5 + g) * 64 + cg4 * 4) = acc[g];
  __syncthreads();
  float* MOD = (float*)(WS(p) + OFF_MOD);
  if (tid < 320) {
    const int g = tid >> 6, cc = tid & 63;
    float s = p.b_mod[l * 6144 + chunk * 64 + cc];
    for (int q = 0; q < 32; ++q) s += red[(q * 5 + g) * 64 + cc];
    MOD[(l * 5 + g) * 6144 + chunk * 64 + cc] = s;
  }
  __syncthreads();
}
__device__ void job_rope(const Params& p, int wb) {
  float* cosT = (float*)(WS(p) + OFF_ROPE);
  float* sinT = cosT + 1024;
  for (int t = otid(); t < 1024; t += NTHR) {
    const int pos = t >> 4, i = t & 15;
    const float inv = exp2f(-(float)i * (13.287712379549449f / 16.f));
    const float a = (float)pos * inv;
    cosT[t] = cosf(a); sinT[t] = sinf(a);
  }
}
__device__ void job_cache(const Params& p, int wb, int j) {
  const float* src; bf16_t* dst; int jj;
  if (j < 256) { src = p.cache_diff_k; dst = (bf16_t*)(WS(p) + OFF_CDK); jj = j; }
  else if (j < 512) { src = p.cache_diff_v; dst = (bf16_t*)(WS(p) + OFF_CDV); jj = j - 256; }
  else if (j < 576) { src = p.cache_win_k; dst = (bf16_t*)(WS(p) + OFF_CWK); jj = j - 512; }
  else { src = p.cache_win_v; dst = (bf16_t*)(WS(p) + OFF_CWV); jj = j - 576; }
  const size_t e = (size_t)jj * 4096 + otid() * 8;
  const f32x4 a = *(const f32x4*)(src + e), b = *(const f32x4*)(src + e + 4);
  u32x4 o; o.x = cvtpk(a[0], a[1]); o.y = cvtpk(a[2], a[3]); o.z = cvtpk(b[0], b[1]); o.w = cvtpk(b[2], b[3]);
  *(u32x4*)(dst + e) = o;
}
struct TileJob { const float* src; bf16_t* dst; int K, N, k0, n0; };
__device__ __forceinline__ TileJob tile_job(const Params& p, int l, int r) {
  TileJob t;
  if (r < 240) { t.src = p.w_in + (size_t)l * 1024 * 3840; t.K = 1024; t.N = 3840; t.dst = (bf16_t*)(WS(p) + OFF_WCAT + l * SZ_WCAT); }
  else if ((r -= 240) < 192) { t.src = p.w_gate + (size_t)l * 1024 * 3072; t.K = 1024; t.N = 3072; t.dst = (bf16_t*)(WS(p) + OFF_WCAT + l * SZ_WCAT) + (size_t)3840 * 1024; }
  else if ((r -= 192) < 32) { t.src = p.w_pa + (size_t)l * 512 * 1024; t.K = 512; t.N = 1024; t.dst = (bf16_t*)(WS(p) + OFF_WP + l * SZ_WP); }
  else if ((r -= 32) < 32) { t.src = p.w_pb + (size_t)l * 512 * 1024; t.K = 512; t.N = 1024; t.dst = (bf16_t*)(WS(p) + OFF_WP + l * SZ_WP) + (size_t)1024 * 512; }
  else if ((r -= 32) < 32) { t.src = p.w_pc + (size_t)l * 512 * 1024; t.K = 512; t.N = 1024; t.dst = (bf16_t*)(WS(p) + OFF_WP + l * SZ_WP) + (size_t)2 * 1024 * 512; }
  else if ((r -= 32) < 64) { t.src = p.w_o + (size_t)l * 1024 * 1024; t.K = 1024; t.N = 1024; t.dst = (bf16_t*)(WS(p) + OFF_WO + l * SZ_WO); }
  else if ((r -= 64) < 256) { t.src = p.w_ff1 + (size_t)l * 1024 * 4096; t.K = 1024; t.N = 4096; t.dst = (bf16_t*)(WS(p) + OFF_WF1 + l * SZ_WF); }
  else { r -= 256; t.src = p.w_ff2 + (size_t)l * 4096 * 1024; t.K = 4096; t.N = 1024; t.dst = (bf16_t*)(WS(p) + OFF_WF2 + l * SZ_WF); }
  const int ntn = t.N >> 7;
  t.k0 = (r / ntn) * 128; t.n0 = (r % ntn) * 128;
  return t;
}
__device__ __forceinline__ void tile_load(const TileJob& t, f32x4 (&v)[8], int tid) {
#pragma unroll
  for (int i = 0; i < 8; ++i) v[i] = *(const f32x4*)(t.src + (size_t)(t.k0 + (tid >> 5) + 16 * i) * t.N + t.n0 + (tid & 31) * 4);
}
__device__ __forceinline__ void tile_to_lds(const f32x4 (&v)[8], float* tile, int tid) {
#pragma unroll
  for (int i = 0; i < 8; ++i) {
    const int k = (tid >> 5) + 16 * i, n4 = (tid & 31) * 4;
    const int kb = k * 129 + (k >> 5) * 8;
    tile[kb + n4 + 0] = v[i][0]; tile[kb + n4 + 1] = v[i][1]; tile[kb + n4 + 2] = v[i][2]; tile[kb + n4 + 3] = v[i][3];
  }
}
__device__ __forceinline__ void tile_store(const TileJob& t, const float* tile, int tid) {
  const int n = tid >> 2, kc = (tid & 3) * 32, sk = (tid & 3) * 8;
  bf16_t* d = t.dst + (size_t)(t.n0 + n) * t.K + t.k0 + kc;
#pragma unroll
  for (int q = 0; q < 4; ++q) {
    u32x4 o;
    o.x = cvtpk(tile[(kc + q * 8 + 0) * 129 + sk + n], tile[(kc + q * 8 + 1) * 129 + sk + n]); o.y = cvtpk(tile[(kc + q * 8 + 2) * 129 + sk + n], tile[(kc + q * 8 + 3) * 129 + sk + n]);
    o.z = cvtpk(tile[(kc + q * 8 + 4) * 129 + sk + n], tile[(kc + q * 8 + 5) * 129 + sk + n]); o.w = cvtpk(tile[(kc + q * 8 + 6) * 129 + sk + n], tile[(kc + q * 8 + 7) * 129 + sk + n]);
    *(u32x4*)(d + q * 8) = o;
  }
}
__device__ void convert_tile(const Params& p, int wb, int l, int r, char* lds) {
  const int tid = otid();
  const TileJob t = tile_job(p, l, r);
  f32x4 v[8];
  tile_load(t, v, tid);
  tile_to_lds(v, (float*)lds, tid);
  __syncthreads();
  tile_store(t, (const float*)lds, tid);
  __syncthreads();
}
constexpr int NJ_MOD = 192, NJ_ROPE = 1, NJ_CACHE = 640, NJ_TR0 = 592;
constexpr int NJ_TOTAL = NJ_MOD + NJ_ROPE + NJ_CACHE + NJ_TR0;
__device__ void phase0(const Params& p, int wb, char* lds) {
  const int b = (int)blockIdx.x;
  if (b < NJ_MOD) job_mod(p, wb, b, lds);
  else if (b == NJ_MOD) job_rope(p, wb);
  constexpr int NREST = NJ_CACHE + NJ_TR0;
  for (int s = b; s < 320; s += (b < NJ_MOD ? 320 : 64))
    for (int r = s; r < NREST; r += 320) {
      if (r < NJ_CACHE) job_cache(p, wb, r);
      else convert_tile(p, wb, 0, r - NJ_CACHE, lds);
    }
}
constexpr int NJ_DEF = 512 + 1104, NJ_DEF_ITEMS = (NJ_DEF + 3) / 4;
__device__ __forceinline__ TileJob deferred_job(const Params& p, int j) { return j < 512 ? tile_job(p, 0, 592 + j) : tile_job(p, 1, j - 512); }
__device__ void deferred_convert(const Params& p, int wb, int j0, int j1, char* lds) {
  const int tid = otid();
  int j = j0;
  if (j >= j1) return;
  TileJob cur = deferred_job(p, j);
  f32x4 v[8];
  tile_load(cur, v, tid);
  for (;;) {
    tile_to_lds(v, (float*)lds, tid);
    __syncthreads();
    const int jn = j + 1;
    TileJob nxt = cur;
    if (jn < j1) { nxt = deferred_job(p, jn); tile_load(nxt, v, tid); }
    tile_store(cur, (const float*)lds, tid);
    __syncthreads();
    if (jn >= j1) break;
    cur = nxt; j = jn;
  }
}
__device__ void phase_h0(const Params& p, int wb) {
  const float* MOD = (const float*)(WS(p) + OFF_MOD);
  bf16_t* H = (bf16_t*)(WS(p) + OFF_H);
  const int stride = (int)gridDim.x * NTHR;
  for (int v0 = blockIdx.x * NTHR + otid(); v0 < 8192 * 128; v0 += 4 * stride) {
    f32x4 a[4], b[4];
#pragma unroll
    for (int e = 0; e < 4; ++e) {
      const int v = v0 + e * stride;
      if (v < 8192 * 128) {
        const int row = v >> 7, c8 = (v & 127) * 8;
        const float* x = (row < 4096 ? p.x_prompt + (size_t)row * 1024 : p.x_sample + (size_t)(row - 4096) * 1024) + c8;
        a[e] = *(const f32x4*)x; b[e] = *(const f32x4*)(x + 4);
      }
    }
#pragma unroll
    for (int e = 0; e < 4; ++e) {
      const int v = v0 + e * stride;
      if (v < 8192 * 128) {
        const int row = v >> 7, c8 = (v & 127) * 8;
        const float* md = MOD + row_group(row) * 6144;
        const f32x4 sh0 = *(const f32x4*)(md + c8), sh1 = *(const f32x4*)(md + c8 + 4);
        const f32x4 sc0 = *(const f32x4*)(md + 1024 + c8), sc1 = *(const f32x4*)(md + 1024 + c8 + 4);
        const f32x4 h0 = a[e] * (sc0 + 1.f) + sh0, h1 = b[e] * (sc1 + 1.f) + sh1;
        u32x4 o; o.x = cvtpk(h0[0], h0[1]); o.y = cvtpk(h0[2], h0[3]); o.z = cvtpk(h1[0], h1[1]); o.w = cvtpk(h1[2], h1[3]);
        *(u32x4*)(H + (size_t)row * 1024 + c8) = o;
      }
    }
  }
}

template <int KW> __device__ __forceinline__ int kaddr(int row, int ch) { return row * (KW * 2) + ((ch ^ (row & (KW / 8 - 1))) << 4); }
template <int DV> __device__ __forceinline__ int vaddr(int row, int boff) {
  if (DV == 128) return row * 256 + (boff ^ ((row & 7) << 5));
  return row * 128 + (boff ^ (((row >> 1) & 3) << 5));
}
template <int NMAPS, int DV>
__device__ __forceinline__ void attn_unit(int wbase, char* lds, const bf16_t* qp, int ldq,
                                          const bf16_t* K0, const bf16_t* V0, int ld0, int key0, int nt0,
                                          const bf16_t* K1, const bf16_t* V1, int ld1, int nt1,
                                          bool window, int qpos0, float m_init, float l_init,
                                          f32x4 (&o)[NMAPS][DV / 16], float (&lsum)[NMAPS]) {
  constexpr int KW = NMAPS * 64, NCHK = KW / 8, NKR = NCHK / 4, NVC = DV / 8, NVR = NVC / 4, KHB = 64 * KW * 2, VHB = 64 * DV * 2;
  const int tid = otid_w(wbase), lane = tid & 63, fr = lane & 15, fq = lane >> 4;
  bf16x8 qf[NMAPS][2];
#pragma unroll
  for (int mp = 0; mp < NMAPS; ++mp)
#pragma unroll
    for (int ks = 0; ks < 2; ++ks) qf[mp][ks] = *(const bf16x8*)(qp + (size_t)fr * ldq + mp * 64 + ks * 32 + fq * 8);
  float m[NMAPS], lr[NMAPS];
#pragma unroll
  for (int mp = 0; mp < NMAPS; ++mp) {
    m[mp] = m_init; lr[mp] = (fq == 0) ? l_init : 0.f;
#pragma unroll
    for (int c = 0; c < DV / 16; ++c) o[mp][c] = (f32x4){0.f, 0.f, 0.f, 0.f};
  }
  const int NT = nt0 + nt1;
  u32x4 kr[NKR], vr[NVR];
  auto load_tile = [&](int t) {
    const bf16_t* kp; const bf16_t* vp; int ld;
    if (t < nt0) { kp = K0 + (size_t)(key0 + t * 128) * ld0; vp = V0 + (size_t)(key0 + t * 128) * ld0; ld = ld0; }
    else { kp = K1 + (size_t)((t - nt0) * 128) * ld1; vp = V1 + (size_t)((t - nt0) * 128) * ld1; ld = ld1; }
#pragma unroll
    for (int i = 0; i < NKR; ++i) { const int idx = tid + NTHR * i, row = idx / NCHK, ch = idx % NCHK; kr[i] = *(const u32x4*)(kp + (size_t)row * ld + ch * 8); }
#pragma unroll
    for (int i = 0; i < NVR; ++i) { const int idx = tid + NTHR * i, row = idx / NVC, ch = idx % NVC; vr[i] = *(const u32x4*)(vp + (size_t)row * ld + ch * 8); }
  };
  load_tile(0);
  for (int t = 0; t < NT; ++t) {
    __syncthreads();
#pragma unroll
    for (int i = 0; i < NKR; ++i) { const int idx = tid + NTHR * i, row = idx / NCHK, ch = idx % NCHK; *(u32x4*)(lds + (row >> 6) * KHB + kaddr<KW>(row & 63, ch)) = kr[i]; }
#pragma unroll
    for (int i = 0; i < NVR; ++i) { const int idx = tid + NTHR * i, row = idx / NVC, ch = idx % NVC; *(u32x4*)(lds + 32768 + (row >> 6) * VHB + vaddr<DV>(row & 63, ch * 16)) = vr[i]; }
    __syncthreads();
    if (t + 1 < NT) load_tile(t + 1);
#pragma unroll
    for (int hf = 0; hf < 2; ++hf) {
      const char* kl = lds + hf * KHB;
      const char* vl = lds + 32768 + hf * VHB;
      bf16x8 pb[NMAPS][2];
#pragma unroll
      for (int mp = 0; mp < NMAPS; ++mp) {
        f32x4 s[4];
#pragma unroll
        for (int ksub = 0; ksub < 4; ++ksub) {
          s[ksub] = (f32x4){0.f, 0.f, 0.f, 0.f};
#pragma unroll
          for (int ks = 0; ks < 2; ++ks) {
            const bf16x8 kf = *(const bf16x8*)(kl + kaddr<KW>(ksub * 16 + fr, mp * 8 + ks * 4 + fq));
            s[ksub] = mfma16(kf, qf[mp][ks], s[ksub]);
          }
        }
        if (window && t < nt0) {
          const int qpos = qpos0 + fr, kb = key0 + t * 128 + hf * 64 + fq * 4;
#pragma unroll
          for (int ksub = 0; ksub < 4; ++ksub)
#pragma unroll
            for (int j = 0; j < 4; ++j) { const int d = kb + ksub * 16 + j - qpos; if (d > 128 || d < -128) s[ksub][j] = -1e30f; }
        }
        float mx = s[0][0];
#pragma unroll
        for (int ksub = 0; ksub < 4; ++ksub)
#pragma unroll
          for (int j = 0; j < 4; ++j) mx = fmaxf(mx, s[ksub][j]);
        mx = quad_max(mx);
        const float mnew = fmaxf(m[mp], mx * LOG2E);
        const float alpha = __builtin_amdgcn_exp2f(m[mp] - mnew);
        m[mp] = mnew;
        float ps = 0.f;
#pragma unroll
        for (int ksub = 0; ksub < 4; ++ksub)
#pragma unroll
          for (int j = 0; j < 4; ++j) { const float pv = __builtin_amdgcn_exp2f(s[ksub][j] * LOG2E - mnew); s[ksub][j] = pv; ps += pv; }
        lr[mp] = lr[mp] * alpha + ps;
        if (__any(alpha != 1.f)) {
#pragma unroll
          for (int c = 0; c < DV / 16; ++c) o[mp][c] *= alpha;
        }
#pragma unroll
        for (int kk = 0; kk < 2; ++kk) {
          u32x4 w; w.x = cvtpk(s[2 * kk][0], s[2 * kk][1]); w.y = cvtpk(s[2 * kk][2], s[2 * kk][3]);
          w.z = cvtpk(s[2 * kk + 1][0], s[2 * kk + 1][1]); w.w = cvtpk(s[2 * kk + 1][2], s[2 * kk + 1][3]);
          pb[mp][kk] = __builtin_bit_cast(bf16x8, w);
        }
      }
#pragma unroll
      for (int c = 0; c < DV / 16; ++c)
#pragma unroll
        for (int kk = 0; kk < 2; ++kk) {
          const int vrow = kk * 32 + fq * 4 + (fr >> 2), vb = (c * 16 + (lane & 3) * 4) * 2;
          const s16x4 lo = vtr(vl + vaddr<DV>(vrow, vb));
          const s16x4 hi = vtr(vl + vaddr<DV>(vrow + 16, vb));
          const bf16x8 vf = cat8(lo, hi);
#pragma unroll
          for (int mp = 0; mp < NMAPS; ++mp) o[mp][c] = mfma16(vf, pb[mp][kk], o[mp][c]);
        }
    }
  }
#pragma unroll
  for (int mp = 0; mp < NMAPS; ++mp) lsum[mp] = quad_sum(lr[mp]);
}

__device__ void unitA(const Params& p, int wb, int l, char* lds, int b_all, int h, int qb) {
  const bf16_t* Z = (const bf16_t*)(WS(p) + OFF_Z);
  const int tid = otid(), lane = tid & 63, wid = tid >> 6, fr = lane & 15, fq = lane >> 4;
  const bool lat = b_all >= 16; const int b = lat ? b_all - 16 : b_all;
  const int rowbase = lat ? 4096 + b * 1024 : b * 256;
  const int q0 = qb * 128 + wid * 16;
  const bf16_t* qp = Z + (size_t)(rowbase + q0) * 3840 + h * 128;
  const bf16_t* K0 = Z + (size_t)rowbase * 3840 + 512 + h * 128;
  const bf16_t* V0 = Z + (size_t)rowbase * 3840 + 1024 + h * 128;
  const bf16_t* K1 = (const bf16_t*)(WS(p) + OFF_CDK) + (size_t)((b * 2 + l) * 256) * 512 + h * 128;
  const bf16_t* V1 = (const bf16_t*)(WS(p) + OFF_CDV) + (size_t)((b * 2 + l) * 256) * 512 + h * 128;
  f32x4 o[2][8]; float ls[2];
  attn_unit<2, 128>(wb, lds, qp, 3840, K0, V0, 3840, 0, lat ? 8 : 2, K1, V1, 512, lat ? 2 : 0, false, 0, -1e30f, 0.f, o, ls);
  const float* lv = p.diff_lam + l * 256;
  const float d1 = wave_sum(lv[lane] * lv[64 + lane]), d2 = wave_sum(lv[128 + lane] * lv[192 + lane]);
  const float lam_init = p.lam_init[l];
  const float lam = expf(d1) - expf(d2) + lam_init;
  const float i0 = 1.f / ls[0], i1 = lam / ls[1];
  float ss = 0.f;
#pragma unroll
  for (int c = 0; c < 8; ++c) {
    o[0][c] = o[0][c] * i0 - o[1][c] * i1;
#pragma unroll
    for (int j = 0; j < 4; ++j) ss += o[0][c][j] * o[0][c][j];
  }
  ss = quad_sum(ss);
  const float r = rsqrtf(ss * (1.f / 128.f) + LN_EPS) * (1.f - lam_init);
  bf16_t* OA = (bf16_t*)(WS(p) + OFF_OA) + (size_t)(rowbase + q0 + fr) * 512 + h * 128 + fq * 4;
  const float* gn = p.diff_norm_g + l * 128 + fq * 4;
#pragma unroll
  for (int c = 0; c < 8; ++c) { const f32x4 g = *(const f32x4*)(gn + c * 16); *(u32x2*)(OA + c * 16) = pack4(o[0][c] * g * r); }
}
__device__ void unitB(const Params& p, int wb, int l, char* lds, int b_all, int kvh, int qb) {
  const bf16_t* Z = (const bf16_t*)(WS(p) + OFF_Z);
  const int tid = otid(), lane = tid & 63, wid = tid >> 6, fr = lane & 15, fq = lane >> 4;
  const bool lat = b_all >= 16; const int b = lat ? b_all - 16 : b_all;
  const int rowbase = lat ? 4096 + b * 1024 : b * 256;
  const int q0b = qb * 32, q0 = q0b + (wid >> 2) * 16, head = kvh * 4 + (wid & 3);
  const bf16_t* qp = Z + (size_t)(rowbase + q0) * 3840 + 1536 + head * 64;
  const bf16_t* K0 = Z + (size_t)rowbase * 3840 + 2048 + kvh * 64;
  const bf16_t* V0 = Z + (size_t)rowbase * 3840 + 2176 + kvh * 64;
  const bf16_t* K1 = (const bf16_t*)(WS(p) + OFF_CWK) + (size_t)((b * 2 + l) * 256) * 128 + kvh * 64;
  const bf16_t* V1 = (const bf16_t*)(WS(p) + OFF_CWV) + (size_t)((b * 2 + l) * 256) * 128 + kvh * 64;
  int key0 = 0, nt0 = 2, nt1 = 0;
  if (lat) {
    const int lo = q0b - 128 < 0 ? 0 : q0b - 128, hi = q0b + 159 > 1023 ? 1023 : q0b + 159;
    key0 = (lo >> 7) << 7; nt0 = (hi >> 7) - (lo >> 7) + 1; nt1 = 2;
  }
  const float sink = p.win_sink[l * 8 + head];
  f32x4 o[1][4]; float ls[1];
  attn_unit<1, 64>(wb, lds, qp, 3840, K0, V0, 3840, key0, nt0, K1, V1, 128, nt1, lat, q0, sink * LOG2E, 1.f, o, ls);
  const float inv = 1.f / ls[0];
  bf16_t* OB = (bf16_t*)(WS(p) + OFF_OB) + (size_t)(rowbase + q0 + fr) * 512 + head * 64 + fq * 4;
#pragma unroll
  for (int c = 0; c < 4; ++c) *(u32x2*)(OB + c * 16) = pack4(o[0][c] * inv);
}

__device__ void unitC(const Params& p, int wb, int l, char* lds, int b_all, int h, int dir) {
  const bf16_t* Z = (const bf16_t*)(WS(p) + OFF_Z);
  float* YF = (float*)(WS(p) + (dir ? OFF_YB : OFF_MRG));
  const int tid = otid(), lane = tid & 63, fr = lane & 15, fq = lane >> 4;
  const int wave = __builtin_amdgcn_readfirstlane(tid >> 6);
  const bool lat = b_all >= 16; const int b = lat ? b_all - 16 : b_all;
  const int rowbase = lat ? 4096 + b * 1024 : b * 256, nc = lat ? 8 : 2;
  {
    const float xd = p.ret_decay[(l * 2 + dir) * 4 + h];
    const float lg2 = -log2f(1.f + expf(-xd));
    const float g128 = exp2f(128.f * lg2);
    f32x4 st[4];
    if (lat) {
      const float* s0 = p.state_ret + (size_t)((((b * 2 + l) * 2 + dir) * 4 + h)) * 8192;
#pragma unroll
      for (int bb = 0; bb < 4; ++bb) st[bb] = *(const f32x4*)(s0 + (bb * 16 + fr) * 128 + wave * 16 + fq * 4);
    } else {
#pragma unroll
      for (int bb = 0; bb < 4; ++bb) st[bb] = (f32x4){0.f, 0.f, 0.f, 0.f};
    }
    u32x4 kzr[2], vr4[4];
    auto load_chunk = [&](int cc_) {
      const int rr = rowbase + (dir ? nc - 1 - cc_ : cc_) * 128;
#pragma unroll
      for (int i = 0; i < 2; ++i) { const int idx = tid + NTHR * i, row = idx >> 3, ch = idx & 7; kzr[i] = *(const u32x4*)(Z + (size_t)(rr + row) * 3840 + 2560 + h * 64 + ch * 8); }
#pragma unroll
      for (int i = 0; i < 4; ++i) { const int idx = tid + NTHR * i, row = idx >> 4, ch = idx & 15; vr4[i] = *(const u32x4*)(Z + (size_t)(rr + row) * 3840 + 2816 + h * 128 + ch * 8); }
    };
    load_chunk(0);
#pragma unroll 1
    for (int cc = 0; cc < nc; ++cc) {
      const int c = dir ? nc - 1 - cc : cc;
      const int r0 = rowbase + c * 128;
      __syncthreads();
#pragma unroll
      for (int bb = 0; bb < 4; ++bb) {
        st[bb] *= g128;
        *(u32x2*)(lds + 16384 + vaddr<128>(bb * 16 + fr, (wave * 16 + fq * 4) * 2)) = pack4(st[bb]);
      }
#pragma unroll
      for (int i = 0; i < 2; ++i) {
        const int idx = tid + NTHR * i, row = idx >> 3, ch = idx & 7;
        const u32x4 v = kzr[i];
        const float zeta = exp2f(lg2 * (float)(dir ? row : 127 - row));
        u32x4 w;
        w.x = cvtpk(bflo(v.x) * zeta, bfhi(v.x) * zeta); w.y = cvtpk(bflo(v.y) * zeta, bfhi(v.y) * zeta);
        w.z = cvtpk(bflo(v.z) * zeta, bfhi(v.z) * zeta); w.w = cvtpk(bflo(v.w) * zeta, bfhi(v.w) * zeta);
        *(u32x4*)(lds + row * 128 + ((ch ^ (row & 7)) << 4)) = w;
      }
#pragma unroll
      for (int i = 0; i < 4; ++i) {
        const int idx = tid + NTHR * i, row = idx >> 4, ch = idx & 15;
        *(u32x4*)(lds + 32768 + vaddr<128>(row, ch * 16)) = vr4[i];
      }
      __syncthreads();
      if (cc + 1 < nc) load_chunk(cc + 1);
      {
        const int qw0 = wave * 16;
        const bf16_t* qbase = Z + (size_t)(r0 + qw0 + fr) * 3840 + 2304 + h * 64;
        f32x4 acc[8];
        {
          bf16x8 qx[2];
#pragma unroll
          for (int ks = 0; ks < 2; ++ks) {
            const u32x2 lo = *(const u32x2*)(qbase + ks * 32 + fq * 4);
            const u32x2 hi = *(const u32x2*)(qbase + ks * 32 + 16 + fq * 4);
            u32x4 w; w.x = lo.x; w.y = lo.y; w.z = hi.x; w.w = hi.y;
            qx[ks] = __builtin_bit_cast(bf16x8, w);
          }
#pragma unroll
          for (int c8 = 0; c8 < 8; ++c8) {
            acc[c8] = (f32x4){0.f, 0.f, 0.f, 0.f};
#pragma unroll
            for (int ks = 0; ks < 2; ++ks) {
              const int srow = ks * 32 + fq * 4 + (fr >> 2), sb = (c8 * 16 + (lane & 3) * 4) * 2;
              const bf16x8 sf = cat8(vtr(lds + 16384 + vaddr<128>(srow, sb)), vtr(lds + 16384 + vaddr<128>(srow + 16, sb)));
              acc[c8] = mfma16(sf, qx[ks], acc[c8]);
            }
          }
        }
        bf16x8 qf[2];
#pragma unroll
        for (int ks = 0; ks < 2; ++ks) qf[ks] = *(const bf16x8*)(qbase + ks * 32 + fq * 8);
#pragma unroll
        for (int kk = 0; kk < 4; ++kk) {
          if (dir == 0 ? (kk * 32 > qw0 + 15) : (kk * 32 + 31 < qw0)) continue;
          f32x4 s0 = (f32x4){0.f, 0.f, 0.f, 0.f}, s1 = (f32x4){0.f, 0.f, 0.f, 0.f};
#pragma unroll
          for (int ks = 0; ks < 2; ++ks) {
            const int co = ((ks * 4 + fq) ^ (fr & 7)) << 4;
            const bf16x8 k0f = *(const bf16x8*)(lds + (kk * 32 + fr) * 128 + co);
            const bf16x8 k1f = *(const bf16x8*)(lds + (kk * 32 + 16 + fr) * 128 + co);
            s0 = mfma16(k0f, qf[ks], s0); s1 = mfma16(k1f, qf[ks], s1);
          }
          const int qtok = qw0 + fr, kt0 = kk * 32 + fq * 4;
#pragma unroll
          for (int j = 0; j < 4; ++j) {
            const int ka = kt0 + j, kb = kt0 + 16 + j;
            const bool keepa = dir == 0 ? (ka <= qtok) : (ka >= qtok);
            const bool keepb = dir == 0 ? (kb <= qtok) : (kb >= qtok);
            s0[j] = keepa ? s0[j] : 0.f; s1[j] = keepb ? s1[j] : 0.f;
          }
          u32x4 w; w.x = cvtpk(s0[0], s0[1]); w.y = cvtpk(s0[2], s0[3]); w.z = cvtpk(s1[0], s1[1]); w.w = cvtpk(s1[2], s1[3]);
          const bf16x8 pb = __builtin_bit_cast(bf16x8, w);
#pragma unroll
          for (int c8 = 0; c8 < 8; ++c8) {
            const int vrow = kk * 32 + fq * 4 + (fr >> 2), vb = (c8 * 16 + (lane & 3) * 4) * 2;
            const bf16x8 vf = cat8(vtr(lds + 32768 + vaddr<128>(vrow, vb)), vtr(lds + 32768 + vaddr<128>(vrow + 16, vb)));
            acc[c8] = mfma16(vf, pb, acc[c8]);
          }
        }
        {
          const int qtok = qw0 + fr;
          const float rowfac = exp2f(lg2 * (float)(dir ? -qtok : qtok - 127));
          const int row = r0 + qtok;
          float* yp = YF + (size_t)row * 512 + h * 128 + fq * 4;
#pragma unroll
          for (int c8 = 0; c8 < 8; ++c8) *(f32x4*)(yp + c8 * 16) = acc[c8] * rowfac;
        }
      }
#pragma unroll
      for (int kk = 0; kk < 4; ++kk) {
        const int trow = kk * 32 + fq * 4 + (fr >> 2);
        bf16x8 kz[4];
#pragma unroll
        for (int bb = 0; bb < 4; ++bb) {
          const int col = bb * 16 + (lane & 3) * 4;
          const s16x4 lo = vtr(lds + trow * 128 + (((col >> 3) ^ (trow & 7)) << 4) + (col & 7) * 2);
          const s16x4 hi = vtr(lds + (trow + 16) * 128 + (((col >> 3) ^ (trow & 7)) << 4) + (col & 7) * 2);
          kz[bb] = cat8(lo, hi);
        }
        const int vb = (wave * 16 + (lane & 3) * 4) * 2;
        const bf16x8 vt = cat8(vtr(lds + 32768 + vaddr<128>(trow, vb)), vtr(lds + 32768 + vaddr<128>(trow + 16, vb)));
#pragma unroll
        for (int bb = 0; bb < 4; ++bb) st[bb] = mfma16(vt, kz[bb], st[bb]);
      }
    }
    if (!lat) {
      float* dst = OUTP(p) + OUT_ST + (size_t)((((b * 2 + l) * 2 + dir) * 4 + h)) * 8192;
#pragma unroll
      for (int bb = 0; bb < 4; ++bb) *(f32x4*)(dst + (bb * 16 + fr) * 128 + wave * 16 + fq * 4) = st[bb];
    }
  }
  asm volatile("s_waitcnt vmcnt(0)" ::: "memory");
  __syncthreads();
  if (tid == 0) {
    __builtin_amdgcn_fence(__ATOMIC_RELEASE, "agent");
    asm volatile("s_waitcnt vmcnt(0)" ::: "memory");
    (void)__hip_atomic_fetch_add((unsigned*)(WS(p) + OFF_CNT) + 64 + (l * 20 + b_all) * 4 + h, 1u, __ATOMIC_RELAXED, __HIP_MEMORY_SCOPE_AGENT);
  }
}
__device__ void unitCF(const Params& p, int wb, int l, char* lds, int b_all, int h, int tb) {
  const int tid = otid(), lane = tid & 63, wid = tid >> 6;
  if (tid == 0) {
    unsigned* dn = (unsigned*)(WS(p) + OFF_CNT) + 64 + (l * 20 + b_all) * 4 + h;
    unsigned sp = 0;
    while (__hip_atomic_load(dn, __ATOMIC_RELAXED, __HIP_MEMORY_SCOPE_AGENT) < 2u) { __builtin_amdgcn_s_sleep(2); if (++sp > (1u << 22)) break; }
    __builtin_amdgcn_fence(__ATOMIC_ACQUIRE, "agent");
    asm volatile("s_waitcnt vmcnt(0)" ::: "memory");
  }
  __syncthreads();
  const bf16_t* Z = (const bf16_t*)(WS(p) + OFF_Z);
  const float* YF = (const float*)(WS(p) + OFF_MRG);
  const float* YB = (const float*)(WS(p) + OFF_YB);
  bf16_t* OC = (bf16_t*)(WS(p) + OFF_OC);
  const bool lat = b_all >= 16; const int b = lat ? b_all - 16 : b_all;
  const int row0 = (lat ? 4096 + b * 1024 : b * 256) + tb * 256 + wid * 32;
  const float g0 = p.ret_norm_g[l * 128 + lane * 2], g1 = p.ret_norm_g[l * 128 + lane * 2 + 1];
#pragma unroll 4
  for (int i = 0; i < 32; ++i) {
    const size_t ro = (size_t)(row0 + i) * 512 + h * 128 + lane * 2;
    const f32x2_t a = *(const f32x2_t*)(YF + ro), bq = *(const f32x2_t*)(YB + ro);
    const unsigned cgu = *(const unsigned*)(Z + (size_t)(row0 + i) * 3840 + 3328 + h * 128 + lane * 2);
    float y0 = a.x + bq.x, y1 = a.y + bq.y;
    const float mu = wave_sum(y0 + y1) * (1.f / 128.f);
    y0 -= mu; y1 -= mu;
    const float rstd = rsqrtf(wave_sum(y0 * y0 + y1 * y1) * (1.f / 128.f) + LN_EPS);
    const float c0 = bflo(cgu), c1 = bfhi(cgu);
    const float s0 = c0 * __builtin_amdgcn_rcpf(1.f + __expf(-c0)), s1 = c1 * __builtin_amdgcn_rcpf(1.f + __expf(-c1));
    *(unsigned*)(OC + ro) = cvtpk(y0 * rstd * g0 * s0, y1 * rstd * g1 * s1);
  }
}

#define PG8_FLAGS true, true
__device__ void phase_att(const Params& p, int wb, int l, char* lds, LAS unsigned char* ldsg) {
  unsigned* cnt = (unsigned*)(WS(p) + OFF_CNT) + l;
  for (;;) {
    __syncthreads();
    if (otid() == 0) *(int*)(lds + LDS_FLAG) = (int)atomicAdd(cnt, 1u);
    __syncthreads();
    const int u = __builtin_amdgcn_readfirstlane(*(const int*)(lds + LDS_FLAG));
    if (u >= 1152) break;
    if (u < 32) unitC(p, wb, l, lds, 16 + (u >> 3), (u >> 1) & 3, u & 1);
    else if (u < 160) { const int v = u - 32; unitA(p, wb, l, lds, 16 + (v >> 5), (v >> 3) & 3, v & 7); }
    else if (u < 256) {
      pg8::Gemm g{(const bf16_t*)(WS(p) + OFF_H), (const bf16_t*)(WS(p) + OFF_WCAT + l * SZ_WCAT), 1024, 1024};
      SchedG1 SG; SG.sz.init(8192, 3840, (int)gridDim.x, 0, 16); SG.sg.init(8192, 3072, (int)gridDim.x, 0, 16);
      SchedOne S1; SG.at(768 + (u - 160), S1.u0);
      EpiSplit<EpiG1, false, 1> E{EpiG1{p.ws, p.b_gate, p.out, l}, p.ws, OFF_OA, 256 + l * 1024, ldsg, wb};
      pg8::gemm_phase<EpiSplit<EpiG1, false, 1>, SchedOne, PG8_FLAGS>(ldsg, g, S1, E, wb);
    }
    else if (u < 384) { const int v = u - 256; unitC(p, wb, l, lds, v >> 3, (v >> 1) & 3, v & 1); }
    else if (u < 512) { const int v = u - 384; unitA(p, wb, l, lds, v >> 3, (v >> 1) & 3, v & 1); }
    else if (u < 768) { const int v = u - 512; unitB(p, wb, l, lds, 16 + (v >> 6), (v >> 5) & 1, v & 31); }
    else if (u < 1024) { const int v = u - 768; unitB(p, wb, l, lds, v >> 4, (v >> 3) & 1, v & 7); }
    else if (u < 1088) { const int v = u - 1024; unitCF(p, wb, l, lds, 16 + (v >> 4), (v >> 2) & 3, v & 3); }
    else { const int v = u - 1088; unitCF(p, wb, l, lds, v >> 2, v & 3, 0); }
  }
}

template <bool COMBINE, int NR>
__device__ void ln_rows(const Params& p, int wb, int row_lo, int row_hi, const float* Y, const float* P1, const float* gate, const float* g, const float* bta, const float* md, int sh_off, int sc_off) {
  float* X = OUTP(p) + OUT_X;
  bf16_t* H = (bf16_t*)(WS(p) + OFF_H);
  const int tid = otid(), lane = tid & 63, wid = tid >> 6;
  for (int row0 = row_lo + wid * NR; row0 < row_hi; row0 += 8 * NR) {
    f32x4 v[NR][4];
    if (!COMBINE) {
#pragma unroll
      for (int r = 0; r < NR; ++r)
#pragma unroll
        for (int k = 0; k < 2; ++k) {
          const u32x4 w = *(const u32x4*)((const bf16_t*)Y + (size_t)(row0 + r) * 1024 + k * 512 + lane * 8);
          v[r][2 * k] = unpack4((u32x2){w.x, w.y}); v[r][2 * k + 1] = unpack4((u32x2){w.z, w.w});
        }
    } else {
      const bf16_t* Yb = (const bf16_t*)Y; const bf16_t* Pb = (const bf16_t*)P1;
#pragma unroll
      for (int r = 0; r < NR; ++r)
#pragma unroll
        for (int k = 0; k < 2; ++k) {
          const int cb = k * 512 + lane * 8;
          const u32x4 w0 = *(const u32x4*)(Yb + (size_t)(row0 + r) * 1024 + cb), w1 = *(const u32x4*)(Pb + (size_t)(row0 + r) * 1024 + cb);
          const f32x4 fa = unpack4((u32x2){w0.x, w0.y}) + unpack4((u32x2){w1.x, w1.y}), fb = unpack4((u32x2){w0.z, w0.w}) + unpack4((u32x2){w1.z, w1.w});
          const float* xr = X + (size_t)(row0 + r) * 1024 + cb; const float* gr = gate + row_group(row0 + r) * 6144 + cb;
          v[r][2 * k] = *(const f32x4*)xr * ALPHA_RES + *(const f32x4*)gr * fa;
          v[r][2 * k + 1] = *(const f32x4*)(xr + 4) * ALPHA_RES + *(const f32x4*)(gr + 4) * fb;
        }
    }
#pragma unroll
    for (int r = 0; r < NR; ++r) {
      const int row = row0 + r;
      float s = 0.f;
#pragma unroll
      for (int i = 0; i < 4; ++i) s += (v[r][i][0] + v[r][i][1]) + (v[r][i][2] + v[r][i][3]);
      const float mu = wave_sum(s) * (1.f / 1024.f);
      float q = 0.f;
#pragma unroll
      for (int i = 0; i < 4; ++i) { v[r][i] = v[r][i] - mu; q += (v[r][i][0] * v[r][i][0] + v[r][i][1] * v[r][i][1]) + (v[r][i][2] * v[r][i][2] + v[r][i][3] * v[r][i][3]); }
      const float rstd = rsqrtf(wave_sum(q) * (1.f / 1024.f) + LN_EPS);
      const float* mrow = md ? md + row_group(row) * 6144 : nullptr;
#pragma unroll
      for (int k = 0; k < 2; ++k) {
        const int cb = k * 512 + lane * 8;
        const f32x4 x0 = v[r][2 * k] * rstd * *(const f32x4*)(g + cb) + *(const f32x4*)(bta + cb);
        const f32x4 x1 = v[r][2 * k + 1] * rstd * *(const f32x4*)(g + cb + 4) + *(const f32x4*)(bta + cb + 4);
        *(f32x4*)(X + (size_t)row * 1024 + cb) = x0; *(f32x4*)(X + (size_t)row * 1024 + cb + 4) = x1;
        if (mrow) {
          const f32x4 h0 = x0 * (*(const f32x4*)(mrow + sc_off + cb) + 1.f) + *(const f32x4*)(mrow + sh_off + cb);
          const f32x4 h1 = x1 * (*(const f32x4*)(mrow + sc_off + cb + 4) + 1.f) + *(const f32x4*)(mrow + sh_off + cb + 4);
          const u32x2 a0 = pack4(h0), a1 = pack4(h1);
          *(u32x4*)(H + (size_t)row * 1024 + cb) = (u32x4){a0.x, a0.y, a1.x, a1.y};
        }
      }
    }
  }
}
template <bool COMBINE, int NR>
__device__ void phase_ln(const Params& p, int wb, const float* Y, const float* P1, const float* gate, const float* g, const float* bta, const float* md, int sh_off, int sc_off) {
  const int rpb = 8192 / (int)gridDim.x;
  ln_rows<COMBINE, NR>(p, wb, (int)blockIdx.x * rpb, ((int)blockIdx.x + 1) * rpb, Y, P1, gate, g, bta, md, sh_off, sc_off);
}

#define XB_TMO      128
#define XB_XCNT(j)  (256  + 64 * (j))
#define XB_XSUB(j)  (1280 + 64 * (j))
#define XB_XGEN(j)  (2304 + 64 * (j))
#define XB_TOP      3328
#define XB_TOPGEN   3392
#define XCD_BAR_WORDS 3456
#define XB_SPIN_CAP (1u << 18)
__device__ __forceinline__ unsigned xb_ld(unsigned* p)              { return __hip_atomic_load(p, __ATOMIC_RELAXED, __HIP_MEMORY_SCOPE_AGENT); }
__device__ __forceinline__ unsigned xb_add(unsigned* p, unsigned v) { return __hip_atomic_fetch_add(p, v, __ATOMIC_RELAXED, __HIP_MEMORY_SCOPE_AGENT); }
__device__ __forceinline__ unsigned xb_xcc_id() { return (unsigned)__builtin_amdgcn_s_getreg((3 << 11) | 20) & 0xFu; }
#define XB_SPIN(cond, bar) do { unsigned _sp = 0; while (cond) { __builtin_amdgcn_s_sleep(1); \
    if ((++_sp & 255u) == 0u) { if (xb_ld(&(bar)[XB_TMO])) break; if (_sp > XB_SPIN_CAP) { atomicAdd(&(bar)[XB_TMO], 1u); break; } } } } while (0)
__device__ __forceinline__ void xcd_barrier_post(unsigned* bar, bool t0) { if (t0) (void)xb_add(&bar[XB_XCNT(xb_xcc_id())], 1u); }
__device__ __forceinline__ void xcd_barrier_complete(unsigned* bar, unsigned x, unsigned& nloc, unsigned& nx) {
    const unsigned G = gridDim.x * gridDim.y * gridDim.z;
    unsigned sum, cnt, mine, sp = 0u;
    for (;;) {
        sum = 0u; cnt = 0u; mine = 0u;
#pragma unroll
        for (unsigned j = 0; j < 16; ++j) { const unsigned c = xb_ld(&bar[XB_XCNT(j)]); sum += c; cnt += (c > 0u) ? 1u : 0u; mine = (j == x) ? c : mine; }
        if (sum == G) break;
        __builtin_amdgcn_s_sleep(1);
        if ((++sp & 255u) == 0u) { if (xb_ld(&bar[XB_TMO])) break; if (sp > XB_SPIN_CAP) { atomicAdd(&bar[XB_TMO], 1u); break; } }
    }
    nloc = mine > 0u ? mine : 1u; nx = cnt > 0u ? cnt : 1u;
}
__device__ __forceinline__ void xcd_barrier(unsigned* bar, volatile LAS unsigned* st, bool t0) {
    asm volatile("s_waitcnt vmcnt(0)" ::: "memory");
    __syncthreads();
    if (t0) {
        const unsigned x = xb_xcc_id();
        __builtin_amdgcn_s_waitcnt(0);
        unsigned nloc = st[0], nx = st[1];
        if (nloc == 0u) { xcd_barrier_complete(bar, x, nloc, nx); st[0] = nloc; st[1] = nx; }
        const unsigned old = xb_add(&bar[XB_XSUB(x)], 1u);
        const unsigned gen = old / nloc;
        if (old + 1u == (gen + 1u) * nloc) {
            __builtin_amdgcn_fence(__ATOMIC_RELEASE, "agent");
            asm volatile("s_waitcnt vmcnt(0)" ::: "memory");
            const unsigned og = xb_add(&bar[XB_TOP], 1u);
            const unsigned tg = og / nx;
            if (og + 1u == (tg + 1u) * nx) xb_add(&bar[XB_TOPGEN], 1u);
            else XB_SPIN(xb_ld(&bar[XB_TOPGEN]) == tg, bar);
            __builtin_amdgcn_fence(__ATOMIC_ACQUIRE, "agent");
            xb_add(&bar[XB_XGEN(x)], 1u);
            asm volatile("s_waitcnt vmcnt(0)" ::: "memory");
        } else {
            XB_SPIN(xb_ld(&bar[XB_XGEN(x)]) == gen, bar);
            __builtin_amdgcn_fence(__ATOMIC_ACQUIRE, "agent");
            asm volatile("s_waitcnt vmcnt(0)" ::: "memory");
        }
    }
    __syncthreads();
}
#define GRID_BAR() xcd_barrier((unsigned*)(WS(p) + OFF_BAR), (volatile LAS unsigned*)(ldsg + LDS_ST), otid() == 0)

__global__ void __launch_bounds__(NTHR, 2) fwd_megakernel(Params p) {
  const int wb = __builtin_amdgcn_readfirstlane((int)threadIdx.x) & ~63;
  cg::grid_group grid = cg::this_grid();
  extern __shared__ __attribute__((aligned(16))) unsigned char lds_dyn[];
  char* lds = (char*)lds_dyn;
  LAS unsigned char* ldsg = (LAS unsigned char*)lds_dyn;
  if (p.ws == nullptr) grid.sync();
  { const int t_ = otid(); if (t_ < 4) ((LAS unsigned*)(ldsg + LDS_ST))[t_] = 0u; __syncthreads(); xcd_barrier_post((unsigned*)(WS(p) + OFF_BAR), t_ == 0); }
  phase0(p, wb, lds);
  GRID_BAR();
  phase_h0(p, wb);
  GRID_BAR();
#pragma unroll 1
  for (int l = 0; l < 2; ++l) {
    {
      pg8::Gemm g{(const bf16_t*)(WS(p) + OFF_H), (const bf16_t*)(WS(p) + OFF_WCAT + l * SZ_WCAT), 1024, 1024};
      SchedG1 S; S.sz.init(8192, 3840, (int)gridDim.x, (int)blockIdx.x, 16); S.sg.init(8192, 3072, (int)gridDim.x, (int)blockIdx.x, 16);
      EpiSplit<EpiG1, false, 1> E{EpiG1{p.ws, p.b_gate, p.out, l}, p.ws, OFF_OA, 256 + l * 1024, ldsg, wb};
      pg8::gemm_phase<EpiSplit<EpiG1, false, 1>, SchedG1, PG8_FLAGS>(ldsg, g, S, E, wb);
    }
    GRID_BAR();
    phase_att(p, wb, l, lds, ldsg);
    GRID_BAR();
    {
      pg8::Gemm g{(const bf16_t*)(WS(p) + OFF_OA), (const bf16_t*)(WS(p) + OFF_WP + l * SZ_WP), 512, 512};
      SchedBr S; S.so.init(8192, 1024, (int)gridDim.x, (int)blockIdx.x, 8);
      EpiSplit<EpiG2, true, 2> E{EpiG2{p.ws}, p.ws, OFF_Z, 256 + l * 1024 + 256, ldsg, wb};
      pg8::gemm_phase<EpiSplit<EpiG2, true, 2>, SchedBr, PG8_FLAGS>(ldsg, g, S, E, wb);
      if (l == 0 && blockIdx.x >= 128) { const int i0 = ((int)blockIdx.x - 128) * 5; deferred_convert(p, wb, i0, i0 + 5, lds); }
    }
    GRID_BAR();
    {
      pg8::Gemm g{(const bf16_t*)(WS(p) + OFF_MRG), (const bf16_t*)(WS(p) + OFF_WO + l * SZ_WO), 1024, 1024};
      pg8::StaticOrder S; S.init(8192, 1024, (int)gridDim.x, (int)blockIdx.x, 16);
      const float* xc = l == 0 ? p.x_prompt : p.out + OUT_X;
      const float* xl = l == 0 ? p.x_sample : p.out + OUT_X + (size_t)4096 * 1024;
      EpiSplit<EpiG3, false, 1> E{EpiG3{p.ws, xc, xl, l, 2048}, p.ws, OFF_Z, 256 + l * 1024 + 512, ldsg, wb};
      pg8::gemm_phase<EpiSplit<EpiG3, false, 1>, pg8::StaticOrder, PG8_FLAGS>(ldsg, g, S, E, wb);
      if (l == 0 && blockIdx.x >= 128) { const int i0 = 640 + ((int)blockIdx.x - 128) * 8; deferred_convert(p, wb, i0, i0 + 8 < NJ_DEF ? i0 + 8 : NJ_DEF, lds); }
    }
    GRID_BAR();
    phase_ln<false, 4>(p, wb, (const float*)(WS(p) + OFF_Y), nullptr, nullptr, p.ln1_g + l * 1024, p.ln1_b + l * 1024, (const float*)(WS(p) + OFF_MOD) + l * 5 * 6144, 3072, 4096);
    GRID_BAR();
    {
      pg8::Gemm g{(const bf16_t*)(WS(p) + OFF_H), (const bf16_t*)(WS(p) + OFF_WF1 + l * SZ_WF), 1024, 1024};
      pg8::StaticOrder S; S.init(8192, 4096, (int)gridDim.x, (int)blockIdx.x, 16);
      EpiG4 E{p.ws, wb};
      pg8::gemm_phase<EpiG4, pg8::StaticOrder, PG8_FLAGS>(ldsg, g, S, E, wb);
    }
    GRID_BAR();
    {
      pg8::Gemm g{(const bf16_t*)(WS(p) + OFF_HID), (const bf16_t*)(WS(p) + OFF_WF2 + l * SZ_WF), 4096, 2048};
      SchedSplit2 S; S.so.init(8192, 1024, (int)gridDim.x, (int)blockIdx.x, 32); S.khalf_len = 2048; S.sn = 1;
      EpiSplit<EpiG5, false, 1> E{EpiG5{p.ws}, p.ws, OFF_Z, 256 + l * 1024 + 768, ldsg, wb};
      pg8::gemm_phase<EpiSplit<EpiG5, false, 1>, SchedSplit2, PG8_FLAGS>(ldsg, g, S, E, wb);
    }
    GRID_BAR();
    phase_ln<true, 4>(p, wb, (const float*)(WS(p) + OFF_Y), (const float*)(WS(p) + OFF_OA), (const float*)(WS(p) + OFF_MOD) + l * 5 * 6144 + 5120, p.ln2_g + l * 1024, p.ln2_b + l * 1024,
                   l == 0 ? (const float*)(WS(p) + OFF_MOD) + 5 * 6144 : nullptr, 0, 1024);
    GRID_BAR();
  }
}

extern "C" void kernel_launch(void* const* d_in, const int* in_sizes, int n_in, void* d_out, int out_size, void* d_ws, size_t ws_size, hipStream_t stream) {
  static int grid_blocks = 0;
  if (!grid_blocks) {
    int dev = 0, cus = 0, per_cu = 0;
    (void)hipGetDevice(&dev);
    (void)hipDeviceGetAttribute(&cus, hipDeviceAttributeMultiprocessorCount, dev);
    if (hipFuncSetAttribute((const void*)fwd_megakernel, hipFuncAttributeMaxDynamicSharedMemorySize, LDS_BYTES) != hipSuccess) fprintf(stderr, "hipFuncSetAttribute failed\n");
    (void)hipOccupancyMaxActiveBlocksPerMultiprocessor(&per_cu, fwd_megakernel, NTHR, LDS_BYTES);
    if (per_cu > 1) per_cu = 1;
    if (per_cu < 1) { fprintf(stderr, "occupancy query says 0 blocks per CU\n"); per_cu = 1; }
    grid_blocks = cus * per_cu;
  }
  if (ws_size < WS_NEED) { fprintf(stderr, "workspace too small: %zu < %zu\n", ws_size, (size_t)WS_NEED); return; }
  Params p{};
  const float** f = (const float**)&p;
  for (int i = 0; i < 29; ++i) f[i] = (const float*)d_in[i];
  p.out = (float*)d_out; p.ws = (char*)d_ws;
  p.lam_init[0] = (float)(0.8 - 0.6 * exp(-0.3 * 0.0));
  p.lam_init[1] = (float)(0.8 - 0.6 * exp(-0.3 * 1.0));
  (void)hipMemsetAsync((char*)d_ws + OFF_CNT, 0, OFF_YB - OFF_CNT, stream);
  void* args[] = {&p};
  hipError_t e = hipLaunchCooperativeKernel((void*)fwd_megakernel, dim3(grid_blocks), dim3(NTHR), args, LDS_BYTES, stream);
  if (e != hipSuccess) fprintf(stderr, "cooperative launch failed: %s (grid %d)\n", hipGetErrorString(e), grid_blocks);
}
```

```cpp
#include <hip/hip_runtime.h>
#include <hip/hip_cooperative_groups.h>
#include <cstdio>
#include <cstdint>
#include <cmath>
namespace cg = cooperative_groups;

typedef unsigned short bf16_t;
typedef short bf16x8 __attribute__((ext_vector_type(8)));
typedef float f32x4 __attribute__((ext_vector_type(4)));
typedef unsigned u32x4 __attribute__((ext_vector_type(4)));
typedef unsigned u32x2 __attribute__((ext_vector_type(2)));
typedef short s16x4 __attribute__((ext_vector_type(4)));
typedef __bf16 bf16x2_t __attribute__((ext_vector_type(2)));
typedef float f32x2_t __attribute__((ext_vector_type(2)));
typedef __attribute__((address_space(3))) s16x4* lds_s16x4_ptr;
#define LAS __attribute__((address_space(3)))

#define LOG2E 1.4426950408889634f
#define ALPHA_RES 1.4142135623730951f
#define LN_EPS 1e-5f

constexpr size_t SZ_WCAT = 6912ull * 1024 * 2, SZ_WP = 3ull * 1024 * 512 * 2, SZ_WO = 1024ull * 1024 * 2, SZ_WF = 4096ull * 1024 * 2;
constexpr size_t OFF_WCAT = 0;
constexpr size_t OFF_WP = OFF_WCAT + 2 * SZ_WCAT;
constexpr size_t OFF_WO = OFF_WP + 2 * SZ_WP;
constexpr size_t OFF_WF1 = OFF_WO + 2 * SZ_WO;
constexpr size_t OFF_WF2 = OFF_WF1 + 2 * SZ_WF;
constexpr size_t OFF_CDK = OFF_WF2 + 2 * SZ_WF;
constexpr size_t OFF_CDV = OFF_CDK + 2097152;
constexpr size_t OFF_CWK = OFF_CDV + 2097152;
constexpr size_t OFF_CWV = OFF_CWK + 524288;
constexpr size_t OFF_MOD = OFF_CWV + 524288;
constexpr size_t OFF_ROPE = OFF_MOD + 245760;
constexpr size_t OFF_H = OFF_ROPE + 8192;
constexpr size_t OFF_OA = OFF_H + 16777216;
constexpr size_t OFF_OB = OFF_OA + 8388608;
constexpr size_t OFF_OC = OFF_OB + 8388608;
constexpr size_t OFF_MRG = OFF_OC + 8388608;
constexpr size_t OFF_R = OFF_MRG + 16777216;
constexpr size_t OFF_Z = OFF_R;
constexpr size_t OFF_G = OFF_Z + 8192ull * 3840 * 2;
constexpr size_t OFF_HID = OFF_R;
constexpr size_t OFF_Y = OFF_R + 8192ull * 4096 * 2;
constexpr size_t OFF_CNT = OFF_G + 8192ull * 3072 * 2;
constexpr size_t OFF_BAR = OFF_CNT + 16384;
constexpr size_t OFF_YB = OFF_BAR + 3456 * 4 + 256;
constexpr size_t WS_NEED = OFF_YB + 8192ull * 512 * 4;
constexpr int NTHR = 512;
constexpr int LDS_BYTES = 131072 + 64;
constexpr int LDS_ST = 131072 + 16;
constexpr int LDS_FLAG = 131072;

constexpr size_t OUT_X = 0, OUT_DK = 8388608, OUT_DV = 12582912, OUT_WK = 16777216, OUT_WV = 17825792, OUT_ST = 18874368;

struct Params {
  const float *x_prompt, *x_sample, *c, *cache_diff_k, *cache_diff_v, *cache_win_k, *cache_win_v, *state_ret, *c_ctx;
  const float *w_mod, *b_mod, *w_in, *diff_lam, *diff_norm_g, *win_sink, *ret_decay, *ret_norm_g;
  const float *w_pa, *w_pb, *w_pc, *w_gate, *b_gate, *w_o, *ln1_g, *ln1_b, *w_ff1, *w_ff2, *ln2_g, *ln2_b;
  float* out;
  char* ws;
  float lam_init[2];
};

__device__ __forceinline__ unsigned cvtpk(float lo, float hi) { f32x2_t v = {lo, hi}; bf16x2_t b = __builtin_convertvector(v, bf16x2_t); return __builtin_bit_cast(unsigned, b); }
__device__ __forceinline__ bf16_t f2bf(float f) { return (bf16_t)(cvtpk(f, 0.f) & 0xffffu); }
__device__ __forceinline__ float bf2f(unsigned short b) { return __uint_as_float(((unsigned)b) << 16); }
__device__ __forceinline__ float bflo(unsigned u) { return __uint_as_float(u << 16); }
__device__ __forceinline__ float bfhi(unsigned u) { return __uint_as_float(u & 0xffff0000u); }
__device__ __forceinline__ u32x2 pack4(f32x4 v) { u32x2 r; r.x = cvtpk(v[0], v[1]); r.y = cvtpk(v[2], v[3]); return r; }
__device__ __forceinline__ f32x4 unpack4(u32x2 u) { f32x4 r; r[0] = bflo(u.x); r[1] = bfhi(u.x); r[2] = bflo(u.y); r[3] = bfhi(u.y); return r; }
__device__ __forceinline__ s16x4 vtr(const char* p) { return __builtin_amdgcn_ds_read_tr16_b64_v4i16((lds_s16x4_ptr)(p)); }
__device__ __forceinline__ bf16x8 cat8(s16x4 lo, s16x4 hi) { return (bf16x8){lo[0], lo[1], lo[2], lo[3], hi[0], hi[1], hi[2], hi[3]}; }
__device__ __forceinline__ f32x4 mfma16(bf16x8 a, bf16x8 b, f32x4 c) { return __builtin_amdgcn_mfma_f32_16x16x32_bf16(a, b, c, 0, 0, 0); }
__device__ __forceinline__ float quad_sum(float v) { v += __shfl_xor(v, 16); v += __shfl_xor(v, 32); return v; }
__device__ __forceinline__ float quad_max(float v) { v = fmaxf(v, __shfl_xor(v, 16)); v = fmaxf(v, __shfl_xor(v, 32)); return v; }
__device__ __forceinline__ float wave_sum(float v) {
#pragma unroll
  for (int o = 32; o > 0; o >>= 1) v += __shfl_xor(v, o);
  return v;
}
__device__ __forceinline__ int lane_id() { return (int)__builtin_amdgcn_mbcnt_hi(~0u, __builtin_amdgcn_mbcnt_lo(~0u, 0u)); }
__device__ __forceinline__ int ozero() { int z; asm volatile("s_mov_b32 %0, 0" : "=s"(z)); return z; }
__device__ __forceinline__ int otid_w(int wbase) { asm volatile("" : "+s"(wbase)); return wbase | lane_id(); }
#define otid() otid_w(wb)
__device__ __forceinline__ char* opq(char* w) { return (char*)((uintptr_t)w ^ (uintptr_t)(unsigned)ozero()); }
__device__ __forceinline__ float* opqf(float* w) { return (float*)((uintptr_t)w ^ (uintptr_t)(unsigned)ozero()); }
__device__ __forceinline__ int row_group(int row) { return row < 4096 ? 0 : 1 + ((row - 4096) >> 10); }

#define WS(p) opq((p).ws)
#define OUTP(p) opqf((p).out)

namespace pg8 {
#define PG8_LAS __attribute__((address_space(3)))
constexpr int BM = 256, BK = 64, HALF = 128, HTB = HALF * BK * 2  , STAGE_BYTES = 8 * HTB, NXCD = 8, WGM = 8;

__host__ __device__ __forceinline__ int lds_byte(int r, int c) { const int st = (r >> 4) * 2 + (c >> 5), rr = r & 15, cc = c & 31, ob = rr * 64 + cc * 2; return st * 1024 + (ob ^ (((ob >> 9) & 1) << 5)); }
__host__ __device__ __forceinline__ void stage_rc(int b, int& R, int& C) { const int st = b / 1024, sb = b % 1024, swz = sb ^ (((sb >> 9) & 1) << 5); R = (st >> 1) * 16 + swz / 64; C = (st & 1) * 32 + (swz % 64) / 2; }
__host__ __device__ __forceinline__ int perm32(int rho) { const int n = rho >> 4, i = rho & 15; return 8 * (i >> 2) + 4 * n + (i & 3); }

struct Unit { int pm, pn, ko, sn, slot; };
struct Gemm { const bf16_t* A; const bf16_t* Bt; int ld, K; };

struct StaticOrder {
    int nM, nN, nwg, G, c, kt;
    __host__ __device__ __forceinline__ void init(int M, int N, int G_, int c_, int kt_) { nM = M / BM; nN = N / BM; nwg = nM * nN; G = G_; c = c_; kt = kt_; }
    __host__ __device__ __forceinline__ bool next(int i, Unit& u) const { return at((long)i * G + c, u); }
    __host__ __device__ __forceinline__ bool at(long L, Unit& u) const {
        if (L >= nwg) return false;
        int wgid = (int)L; { const int q = nwg / NXCD, r = nwg % NXCD, xcd = wgid % NXCD, off = wgid / NXCD; wgid = (xcd < r ? xcd * (q + 1) : r * (q + 1) + (xcd - r) * q) + off; }
        const int nig = WGM * nN, gid = wgid / nig, fm = gid * WGM, gsz = (nM - fm) < WGM ? (nM - fm) : WGM;
        u.pm = fm + ((wgid % nig) % gsz); u.pn = (wgid % nig) / gsz; u.ko = 0; u.sn = 1; u.slot = 0; return true;
    }
    __device__ __forceinline__ void a_ready(const Unit&) const {}
    __device__ __forceinline__ void done(const Unit&) const {}
};


template <class Epi, class Sched, bool ALIGN_EPI = false, bool SP2 = false>
__device__ __forceinline__ void gemm_phase(PG8_LAS unsigned char* lds, const Gemm g, const Sched& S, const Epi& E, int wbase) {
    const int tid = otid_w(wbase), wid = __builtin_amdgcn_readfirstlane(tid >> 6), lane = tid & 63, wr = wid >> 2, wc = wid & 3, fr = lane & 15, fq = lane >> 4;
    const int K = g.ld, nt = g.K / BK;
    unsigned voffA[2], voffB[2];
#pragma unroll
    for (int i = 0; i < 2; ++i) { int R, C; stage_rc(tid * 16 + i * 8192, R, C); const int Rb = Epi::PERM ? ((R & ~31) + perm32(R & 31)) : R;
        voffA[i] = (unsigned)(R * K + C) * 2u; voffB[i] = (unsigned)(Rb * K + C) * 2u; }
    const size_t kstep = (size_t)(BK * 2);
    const size_t hstep = (size_t)HALF * K * 2;
    const size_t tstep = 2 * hstep;
    const unsigned ldsw = (unsigned)wid * 1024u;
    const int aoff = lds_byte(wr * 64 + fr, fq * 8), boff = lds_byte(wc * 32 + fr, fq * 8);
#define PG8_SA(b, h) (((b) * 2 + (h)) * HTB)
#define PG8_SB(b, h) ((4 + (b) * 2 + (h)) * HTB)
#define PG8_STAGE(bufoff, gbase, voff) do { _Pragma("unroll") for (int _i = 0; _i < 2; ++_i) \
        __builtin_amdgcn_global_load_lds((const unsigned*)((const char*)(gbase) + (voff)[_i]), (PG8_LAS unsigned*)(lds + (bufoff) + ldsw + _i * 8192), 16, 0, 0); } while (0)
#define PG8_LDA(dst, b, h) do { _Pragma("unroll") for (int m = 0; m < 4; ++m) _Pragma("unroll") for (int k = 0; k < 2; ++k) dst[m][k] = *(const PG8_LAS bf16x8*)(lds + PG8_SA(b, h) + aoff + m * 2048 + k * 1024); } while (0)
#define PG8_LDB(dst, b, h) do { _Pragma("unroll") for (int n = 0; n < 2; ++n) _Pragma("unroll") for (int k = 0; k < 2; ++k) dst[n][k] = *(const PG8_LAS bf16x8*)(lds + PG8_SB(b, h) + boff + n * 2048 + k * 1024); } while (0)
#define PG8_MMA(ai, bj, At, Bt) do { __builtin_amdgcn_s_setprio(1); _Pragma("unroll") for (int m = 0; m < 4; ++m) _Pragma("unroll") for (int n = 0; n < 2; ++n) _Pragma("unroll") for (int k = 0; k < 2; ++k) \
        acc[ai][bj][m][n] = __builtin_amdgcn_mfma_f32_16x16x32_bf16(Bt[n][k], At[m][k], acc[ai][bj][m][n], 0, 0, 0); __builtin_amdgcn_s_setprio(0); } while (0)
#define PG8_WAIT_V(n) asm volatile("s_waitcnt vmcnt(" #n ")" ::: "memory")
#define PG8_WAIT_L(n) asm volatile("s_waitcnt lgkmcnt(" #n ")" ::: "memory")
#define PG8_BAR __builtin_amdgcn_s_barrier()
#define PG8_SCHED __builtin_amdgcn_sched_barrier(0)
    Unit cur, nxt; int ui = 0;
    if (!S.next(0, cur)) return;
    f32x4 acc[2][2][4][2];
#pragma unroll
    for (int a = 0; a < 2; ++a)
#pragma unroll
        for (int b = 0; b < 2; ++b)
#pragma unroll
            for (int m = 0; m < 4; ++m)
#pragma unroll
                for (int n = 0; n < 2; ++n) acc[a][b][m][n] = (f32x4){0.f, 0.f, 0.f, 0.f};
    bf16x8 At[4][2], B0[2][2], B1[2][2];
    const char* cA = (const char*)g.A + (size_t)cur.pm * tstep + (size_t)cur.ko * 2; const char* cB = (const char*)g.Bt + (size_t)cur.pn * tstep + (size_t)cur.ko * 2;
    S.a_ready(cur);
    if constexpr (SP2) {
        PG8_STAGE(PG8_SB(0, 0), cB, voffB); PG8_STAGE(PG8_SB(0, 1), cB + hstep, voffB); PG8_STAGE(PG8_SA(0, 0), cA, voffA); PG8_STAGE(PG8_SA(0, 1), cA + hstep, voffA);
        if (wr == 1) PG8_BAR;
        PG8_WAIT_V(2); PG8_BAR;
        PG8_STAGE(PG8_SB(1, 0), cB + kstep, voffB); PG8_STAGE(PG8_SA(1, 0), cA + kstep, voffA); PG8_STAGE(PG8_SB(1, 1), cB + hstep + kstep, voffB);
        PG8_WAIT_V(6); PG8_BAR;
    } else {
        PG8_STAGE(PG8_SB(0, 0), cB, voffB); PG8_STAGE(PG8_SA(0, 0), cA, voffA); PG8_STAGE(PG8_SB(0, 1), cB + hstep, voffB); PG8_STAGE(PG8_SA(0, 1), cA + hstep, voffA);
        if (wr == 1) PG8_BAR;
        PG8_WAIT_V(4); PG8_BAR;
        PG8_STAGE(PG8_SB(1, 0), cB + kstep, voffB); PG8_STAGE(PG8_SA(1, 0), cA + kstep, voffA); PG8_STAGE(PG8_SB(1, 1), cB + hstep + kstep, voffB);
        PG8_WAIT_V(6); PG8_BAR;
    }
    for (;;) {
        const bool has_next = S.next(ui + 1, nxt);
        const char* nA = has_next ? (const char*)g.A + (size_t)nxt.pm * tstep + (size_t)nxt.ko * 2 : cA; const char* nB = has_next ? (const char*)g.Bt + (size_t)nxt.pn * tstep + (size_t)nxt.ko * 2 : cB;
        const int nt_u = cur.sn == 2 ? (nt >> 1) : nt;
        for (int t = 0; t < nt_u; t += 2) {
            const bool last = (t == nt_u - 2);
            const char* a1 = cA + (size_t)(t + 1) * kstep;
            const char* a2 = last ? nA : cA + (size_t)(t + 2) * kstep; const char* b2 = last ? nB : cB + (size_t)(t + 2) * kstep;
            const char* a3 = a2 + kstep; const char* b3 = b2 + kstep;
            if (last && has_next) S.a_ready(nxt);
            if constexpr (SP2) {
            PG8_LDB(B0, 0, 0); PG8_LDB(B1, 0, 1); PG8_SCHED; PG8_LDA(At, 0, 0); PG8_STAGE(PG8_SA(1, 1), a1 + hstep, voffA);
            PG8_WAIT_V(8); PG8_WAIT_L(0); PG8_BAR; PG8_MMA(0, 0, At, B0); PG8_MMA(0, 1, At, B1); PG8_BAR; PG8_SCHED;
            PG8_LDA(At, 0, 1); PG8_STAGE(PG8_SB(0, 0), b2, voffB); PG8_STAGE(PG8_SB(0, 1), b2 + hstep, voffB); PG8_STAGE(PG8_SA(0, 0), a2, voffA);
            PG8_WAIT_V(8); PG8_WAIT_L(0); PG8_BAR; PG8_MMA(1, 0, At, B0); PG8_MMA(1, 1, At, B1); PG8_BAR; PG8_SCHED;
            PG8_LDB(B0, 1, 0); PG8_LDB(B1, 1, 1); PG8_SCHED; PG8_LDA(At, 1, 0); PG8_STAGE(PG8_SA(0, 1), a2 + hstep, voffA);
            PG8_WAIT_V(8); PG8_WAIT_L(0); PG8_BAR; PG8_MMA(0, 0, At, B0); PG8_MMA(0, 1, At, B1); PG8_BAR; PG8_SCHED;
            PG8_LDA(At, 1, 1); PG8_STAGE(PG8_SB(1, 0), b3, voffB); PG8_STAGE(PG8_SB(1, 1), b3 + hstep, voffB); PG8_STAGE(PG8_SA(1, 0), a3, voffA);
            PG8_WAIT_V(8); PG8_WAIT_L(0); PG8_BAR; PG8_MMA(1, 0, At, B0); PG8_MMA(1, 1, At, B1); PG8_BAR; PG8_SCHED;
            } else {
            PG8_LDB(B0, 0, 0); PG8_SCHED; PG8_LDA(At, 0, 0); PG8_STAGE(PG8_SA(1, 1), a1 + hstep, voffA);
            PG8_WAIT_L(8); PG8_BAR; PG8_WAIT_L(0); PG8_MMA(0, 0, At, B0); PG8_BAR; PG8_SCHED;
            PG8_LDB(B1, 0, 1); PG8_STAGE(PG8_SB(0, 0), b2, voffB);
            PG8_BAR; PG8_WAIT_L(0); PG8_MMA(0, 1, At, B1); PG8_BAR;
            PG8_LDA(At, 0, 1); PG8_STAGE(PG8_SA(0, 0), a2, voffA);
            PG8_BAR; PG8_WAIT_L(0); PG8_MMA(1, 0, At, B0); PG8_BAR; PG8_SCHED;
            PG8_STAGE(PG8_SB(0, 1), b2 + hstep, voffB);
            PG8_WAIT_V(6); PG8_BAR; PG8_MMA(1, 1, At, B1); PG8_BAR;
            PG8_LDB(B0, 1, 0); PG8_SCHED; PG8_LDA(At, 1, 0); PG8_STAGE(PG8_SA(0, 1), a2 + hstep, voffA);
            PG8_WAIT_L(8); PG8_BAR; PG8_WAIT_L(0); PG8_MMA(0, 0, At, B0); PG8_BAR; PG8_SCHED;
            PG8_LDB(B1, 1, 1); PG8_STAGE(PG8_SB(1, 0), b3, voffB);
            PG8_BAR; PG8_WAIT_L(0); PG8_MMA(0, 1, At, B1); PG8_BAR;
            PG8_LDA(At, 1, 1); PG8_STAGE(PG8_SA(1, 0), a3, voffA);
            PG8_BAR; PG8_WAIT_L(0); PG8_MMA(1, 0, At, B0); PG8_BAR; PG8_SCHED;
            PG8_STAGE(PG8_SB(1, 1), b3 + hstep, voffB);
            PG8_WAIT_V(6); PG8_BAR; PG8_MMA(1, 1, At, B1); PG8_BAR;
            }
        }
        if constexpr (ALIGN_EPI) { if (wr == 0) PG8_BAR; }
        if constexpr (!Epi::AFTER_DRAIN) { E(acc, cur, wr, wc, fr, fq); S.done(cur); }
        if (!has_next) break;
#pragma unroll
        for (int a = 0; a < 2; ++a)
#pragma unroll
            for (int b = 0; b < 2; ++b)
#pragma unroll
                for (int m = 0; m < 4; ++m)
#pragma unroll
                    for (int n = 0; n < 2; ++n) acc[a][b][m][n] = (f32x4){0.f, 0.f, 0.f, 0.f};
        cur = nxt; cA = nA; cB = nB; ++ui;
        if constexpr (ALIGN_EPI) { if (wr == 1) PG8_BAR; }
    }
    PG8_WAIT_V(0);
    if constexpr (!ALIGN_EPI) { if (wr == 0) PG8_BAR; }
    PG8_BAR;
    if constexpr (Epi::AFTER_DRAIN) { E.fused(acc, cur, wr, wc, fr, fq, lds, wid, lane); S.done(cur); }
#undef PG8_SA
#undef PG8_SB
#undef PG8_STAGE
#undef PG8_LDA
#undef PG8_LDB
#undef PG8_MMA
#undef PG8_WAIT_V
#undef PG8_WAIT_L
#undef PG8_BAR
#undef PG8_SCHED
}
}

typedef f32x4 AccT[2][2][4][2];
struct SchedG1 {
  pg8::StaticOrder sz, sg;
  __device__ __forceinline__ bool at(int L, pg8::Unit& u) const {
    if (L < 480) return sz.at(L, u);
    if (!sg.at(L - 480, u)) return false;
    u.pn += 15; return true;
  }
  __device__ __forceinline__ bool next(int i, pg8::Unit& u) const { return i < 3 && at(i * 256 + sz.c, u); }
  __device__ __forceinline__ void a_ready(const pg8::Unit&) const {}
  __device__ __forceinline__ void done(const pg8::Unit&) const {}
};
struct SchedOne {
  pg8::Unit u0;
  __device__ __forceinline__ bool next(int i, pg8::Unit& u) const { if (i > 0) return false; u = u0; return true; }
  __device__ __forceinline__ void a_ready(const pg8::Unit&) const {}
  __device__ __forceinline__ void done(const pg8::Unit&) const {}
};
struct SchedBr {
  pg8::StaticOrder so;
  __device__ __forceinline__ bool next(int i, pg8::Unit& u) const {
    if (i > 1 || (i == 1 && so.c >= 128)) return false;
    const int t = so.c & 127, br = i == 0 ? (so.c >> 7) : 2;
    so.at(t, u); u.pm += br * 32; u.pn += br * 4; u.sn = 3; u.slot = t; return true;
  }
  __device__ __forceinline__ void a_ready(const pg8::Unit&) const {}
  __device__ __forceinline__ void done(const pg8::Unit&) const {}
};
struct SchedSplit2 {
  pg8::StaticOrder so; int khalf_len, sn;
  __device__ __forceinline__ bool next(int i, pg8::Unit& u) const {
    if (i >= 1) return false;
    const int t = so.c & 127;
    so.at(t, u); u.ko = (so.c >> 7) * khalf_len; u.sn = sn; u.slot = t; return true;
  }
  __device__ __forceinline__ void a_ready(const pg8::Unit&) const {}
  __device__ __forceinline__ void done(const pg8::Unit&) const {}
};
struct PartRef { __amdgpu_buffer_rsrc_t rs; int voff; };
template <bool BF16P> __device__ __forceinline__ f32x4 part_ld(const PartRef& pr, int soff) {
  if (BF16P) return unpack4(__builtin_bit_cast(u32x2, __builtin_amdgcn_raw_buffer_load_b64(pr.rs, pr.voff, soff, 0)));
  return __builtin_bit_cast(f32x4, __builtin_amdgcn_raw_buffer_load_b128(pr.rs, pr.voff, soff, 0));
}
template <int NP, bool BF16P> __device__ __forceinline__ f32x4 accv(const AccT& acc, int ai, int bj, int m, int n, const PartRef& pr) {
  constexpr int PB = BF16P ? 8 : 16, IMG = 16384 * PB;
  const int q = ai * 16 + bj * 8 + m * 2 + n;
  f32x4 v = acc[ai][bj][m][n];
  if (NP >= 1) v += part_ld<BF16P>(pr, q * 512 * PB);
  if (NP >= 2) v += part_ld<BF16P>(pr, IMG + q * 512 * PB);
  return v;
}
template <class Inner, bool BF16P, int NPC>
struct EpiSplit {
  static constexpr bool PERM = Inner::PERM, AFTER_DRAIN = false;
  Inner in; char* ws; size_t part_off; int cnt_base; LAS unsigned char* ldsp; int wbase;
  __device__ __forceinline__ void operator()(AccT& acc, const pg8::Unit& u, int, int, int, int) const {
    int lane_ = lane_id(), wv_ = wbase; asm volatile("" : "+v"(lane_), "+s"(wv_));
    const int fr = lane_ & 15, fq = lane_ >> 4, wr = wv_ >> 8, wc = (wv_ >> 6) & 3;
    in.pre(acc, u, wr, wc, fr, fq);
    constexpr int PB = BF16P ? 8 : 16, IMG = 16384 * PB;
    if (u.sn == 1) { const PartRef pr0{__builtin_amdgcn_make_buffer_rsrc((void*)ws, (short)0, 0, 0x00020000), 0}; in.template fin<0, BF16P>(acc, u, wr, wc, fr, fq, pr0); return; }
    const int tid = wv_ + lane_;
    char* w_ = opq(ws);
    unsigned* c = (unsigned*)(w_ + OFF_CNT) + cnt_base + u.slot * 2;
    LAS int* role = (LAS int*)(ldsp + LDS_FLAG);
    if (tid == 0) { *role = (int)__hip_atomic_fetch_add(c, 1u, __ATOMIC_RELAXED, __HIP_MEMORY_SCOPE_AGENT); asm volatile("s_waitcnt lgkmcnt(0)" ::: "memory"); }
    __builtin_amdgcn_s_barrier(); asm volatile("" ::: "memory");
    const int r = __builtin_amdgcn_readfirstlane(*role);
    if (r < NPC) {
      const __amdgpu_buffer_rsrc_t rs = __builtin_amdgcn_make_buffer_rsrc((void*)(w_ + part_off + (size_t)(u.slot * NPC + r) * IMG), (short)0, IMG, 0x00020000);
#pragma unroll
      for (int q = 0; q < 32; ++q) {
        if (BF16P) { typedef unsigned v2u_ __attribute__((__vector_size__(2 * sizeof(unsigned)))); const u32x2 t_ = pack4(acc[q >> 4][(q >> 3) & 1][(q >> 1) & 3][q & 1]); __builtin_amdgcn_raw_buffer_store_b64(__builtin_bit_cast(v2u_, t_), rs, tid * PB, q * 512 * PB, 0); }
        else __builtin_amdgcn_raw_buffer_store_b128(__builtin_bit_cast(u32x4, acc[q >> 4][(q >> 3) & 1][(q >> 1) & 3][q & 1]), rs, tid * PB, q * 512 * PB, 0);
      }
      asm volatile("s_waitcnt vmcnt(0)" ::: "memory");
      __builtin_amdgcn_s_barrier(); asm volatile("" ::: "memory");
      if (tid == 0) {
        __builtin_amdgcn_fence(__ATOMIC_RELEASE, "agent");
        asm volatile("s_waitcnt vmcnt(0)" ::: "memory");
        (void)__hip_atomic_fetch_add(c + 1, 1u, __ATOMIC_RELAXED, __HIP_MEMORY_SCOPE_AGENT);
      }
      return;
    }
    if (tid == 0) {
      unsigned sp = 0;
      while (__hip_atomic_load(c + 1, __ATOMIC_RELAXED, __HIP_MEMORY_SCOPE_AGENT) < (unsigned)NPC) { __builtin_amdgcn_s_sleep(1); if (++sp > (1u << 22)) break; }
      __builtin_amdgcn_fence(__ATOMIC_ACQUIRE, "agent");
      asm volatile("s_waitcnt vmcnt(0)" ::: "memory");
    }
    __builtin_amdgcn_s_barrier(); asm volatile("" ::: "memory");
    const PartRef prc{__builtin_amdgcn_make_buffer_rsrc((void*)(w_ + part_off + (size_t)(u.slot * NPC) * IMG), (short)0, NPC * IMG, 0x00020000), tid * PB};
    in.template fin<NPC, BF16P>(acc, u, wr, wc, fr, fq, prc);
  }
};
struct EpiG1 {
  static constexpr bool PERM = true, AFTER_DRAIN = false;
  __device__ __forceinline__ void pre(AccT&, const pg8::Unit&, int, int, int, int) const {}
  char* ws; const float* b_gate; float* out_; int l;
  template <int NP, bool BF16P> __device__ __forceinline__ void fin(const AccT& acc, const pg8::Unit& u, int wr, int wc, int fr, int fq, const PartRef& pb) const {
    char* w_ = opq(ws); float* out = opqf(out_);
    bf16_t* Z = (bf16_t*)(w_ + OFF_Z); bf16_t* G = (bf16_t*)(w_ + OFF_G); const float* cosT = (const float*)(w_ + OFF_ROPE); const float* sinT = cosT + 1024;
    const bool lat = u.pm >= 16;
    const bool lo = fq < 2;
    const int fi = (fq & 1) * 8;
#pragma unroll
    for (int bj = 0; bj < 2; ++bj) {
      const int colg = u.pn * 256 + bj * 128 + wc * 32;
      if (colg < 3840) {
        const bool rope = lat && (colg < 1024 || (colg >= 1536 && colg < 2176));
        const bool second = (colg & 32) != 0;
        const float scl = (colg < 512 || (colg >= 1536 && colg < 2048) || (colg >= 2560 && colg < 2816)) ? 0.125f : 1.f;
        float* outp = nullptr; int outld = 0, outc = 0;
        if (!lat) {
          if (colg >= 512 && colg < 1024) { outp = out + OUT_DK; outld = 512; outc = colg - 512; }
          else if (colg >= 1024 && colg < 1536) { outp = out + OUT_DV; outld = 512; outc = colg - 1024; }
          else if (colg >= 2048 && colg < 2176) { outp = out + OUT_WK; outld = 128; outc = colg - 2048; }
          else if (colg >= 2176 && colg < 2304) { outp = out + OUT_WV; outld = 128; outc = colg - 2176; }
        }
#pragma unroll
        for (int ai = 0; ai < 2; ++ai)
#pragma unroll
          for (int m = 0; m < 4; ++m) {
            const int row = u.pm * 256 + ai * 128 + wr * 64 + m * 16 + fr;
            f32x4 v0 = accv<NP, BF16P>(acc, ai, bj, m, 0, pb), v1 = accv<NP, BF16P>(acc, ai, bj, m, 1, pb);
            if (rope) {
              const int t = (row - 4096) & 1023, pos = second ? (t & 63) : (t >> 6);
              const f32x4 ca = *(const f32x4*)(cosT + pos * 16 + fi), cb = *(const f32x4*)(cosT + pos * 16 + fi + 4);
              const f32x4 sa = *(const f32x4*)(sinT + pos * 16 + fi), sb = *(const f32x4*)(sinT + pos * 16 + fi + 4);
#pragma unroll
              for (int j = 0; j < 4; ++j) {
                const float p0 = __shfl_xor(v0[j], 32), p1 = __shfl_xor(v1[j], 32);
                v0[j] = lo ? v0[j] * ca[j] - p0 * sa[j] : p0 * sa[j] + v0[j] * ca[j];
                v1[j] = lo ? v1[j] * cb[j] - p1 * sb[j] : p1 * sb[j] + v1[j] * cb[j];
              }
            }
            if (outp) {
              float* op = outp + (size_t)(((row >> 8) * 2 + l) * 256 + (row & 255)) * outld + outc + fq * 8;
              *(f32x4*)op = v0; *(f32x4*)(op + 4) = v1;
            }
            const u32x2 a0 = pack4(v0 * scl), a1 = pack4(v1 * scl);
            *(u32x4*)(Z + (size_t)row * 3840 + colg + fq * 8) = (u32x4){a0.x, a0.y, a1.x, a1.y};
          }
      } else {
        const int gc = colg - 3840;
        const f32x4 b0 = *(const f32x4*)(b_gate + l * 3072 + gc + fq * 8), b1 = *(const f32x4*)(b_gate + l * 3072 + gc + fq * 8 + 4);
#pragma unroll
        for (int ai = 0; ai < 2; ++ai)
#pragma unroll
          for (int m = 0; m < 4; ++m) {
            const int row = u.pm * 256 + ai * 128 + wr * 64 + m * 16 + fr;
            f32x4 v0 = accv<NP, BF16P>(acc, ai, bj, m, 0, pb) + b0, v1 = accv<NP, BF16P>(acc, ai, bj, m, 1, pb) + b1;
#pragma unroll
            for (int j = 0; j < 4; ++j) { v0[j] = __builtin_amdgcn_rcpf(1.f + __expf(-v0[j])); v1[j] = __builtin_amdgcn_rcpf(1.f + __expf(-v1[j])); }
            const u32x2 a0 = pack4(v0), a1 = pack4(v1);
            *(u32x4*)(G + (size_t)row * 3072 + gc + fq * 8) = (u32x4){a0.x, a0.y, a1.x, a1.y};
          }
      }
    }
  }
};
struct EpiG2 {
  static constexpr bool PERM = true, AFTER_DRAIN = false;
  char* ws;
  __device__ __forceinline__ void pre(AccT& acc, const pg8::Unit& u, int wr, int wc, int fr, int fq) const {
    const bf16_t* G = (const bf16_t*)(opq(ws) + OFF_G);
    const int br = u.pm >> 5, pm = u.pm & 31, pn = u.pn & 3;
#pragma unroll
    for (int ai = 0; ai < 2; ++ai)
#pragma unroll
      for (int m = 0; m < 4; ++m) {
        const int row = pm * 256 + ai * 128 + wr * 64 + m * 16 + fr;
#pragma unroll
        for (int bj = 0; bj < 2; ++bj) {
          const int col = pn * 256 + bj * 128 + wc * 32 + fq * 8;
          const u32x4 g = *(const u32x4*)(G + (size_t)row * 3072 + br * 1024 + col);
          acc[ai][bj][m][0] *= unpack4((u32x2){g.x, g.y});
          acc[ai][bj][m][1] *= unpack4((u32x2){g.z, g.w});
        }
        asm volatile("" ::: "memory");
      }
  }
  template <int NP, bool BF16P> __device__ __forceinline__ void fin(const AccT& acc, const pg8::Unit& u, int wr, int wc, int fr, int fq, const PartRef& pb) const {
    bf16_t* MRG = (bf16_t*)(opq(ws) + OFF_MRG);
    const int pm = u.pm & 31, pn = u.pn & 3;
#pragma unroll
    for (int ai = 0; ai < 2; ++ai)
#pragma unroll
      for (int m = 0; m < 4; ++m) {
        const int row = pm * 256 + ai * 128 + wr * 64 + m * 16 + fr;
#pragma unroll
        for (int bj = 0; bj < 2; ++bj) {
          const int col = pn * 256 + bj * 128 + wc * 32 + fq * 8;
          const u32x2 a0 = pack4(accv<NP, BF16P>(acc, ai, bj, m, 0, pb)), a1 = pack4(accv<NP, BF16P>(acc, ai, bj, m, 1, pb));
          *(u32x4*)(MRG + (size_t)row * 1024 + col) = (u32x4){a0.x, a0.y, a1.x, a1.y};
        }
      }
  }
};
struct EpiG3 {
  static constexpr bool PERM = true, AFTER_DRAIN = false;
  char* ws; const float* xc_; const float* xl_; int l, goff;
  __device__ __forceinline__ void pre(AccT&, const pg8::Unit&, int, int, int, int) const {}
  template <int NP, bool BF16P> __device__ __forceinline__ void fin(const AccT& acc, const pg8::Unit& u, int wr, int wc, int fr, int fq, const PartRef& pb) const {
    char* w_ = opq(ws);
    const float* xc = opqf((float*)xc_); const float* xl = opqf((float*)xl_);
    const float* mod = (const float*)(w_ + OFF_MOD) + l * 5 * 6144 + goff; bf16_t* Y = (bf16_t*)(w_ + OFF_Y);
#pragma unroll
    for (int ai = 0; ai < 2; ++ai)
#pragma unroll
      for (int m = 0; m < 4; ++m) {
        const int row = u.pm * 256 + ai * 128 + wr * 64 + m * 16 + fr;
        const float* xp = row < 4096 ? xc + (size_t)row * 1024 : xl + (size_t)(row - 4096) * 1024;
        const float* gp = mod + row_group(row) * 6144;
#pragma unroll
        for (int bj = 0; bj < 2; ++bj) {
          const int col = u.pn * 256 + bj * 128 + wc * 32 + fq * 8;
          const u32x2 a0 = pack4(*(const f32x4*)(xp + col) * ALPHA_RES + *(const f32x4*)(gp + col) * accv<NP, BF16P>(acc, ai, bj, m, 0, pb));
          const u32x2 a1 = pack4(*(const f32x4*)(xp + col + 4) * ALPHA_RES + *(const f32x4*)(gp + col + 4) * accv<NP, BF16P>(acc, ai, bj, m, 1, pb));
          *(u32x4*)(Y + (size_t)row * 1024 + col) = (u32x4){a0.x, a0.y, a1.x, a1.y};
        }
      }
  }
};
struct EpiG5 {
  static constexpr bool PERM = true, AFTER_DRAIN = false;
  char* ws;
  __device__ __forceinline__ void pre(AccT&, const pg8::Unit&, int, int, int, int) const {}
  template <int NP, bool BF16P> __device__ __forceinline__ void fin(const AccT& acc, const pg8::Unit& u, int wr, int wc, int fr, int fq, const PartRef&) const {
    bf16_t* P = (bf16_t*)(opq(ws) + (u.ko ? OFF_OA : OFF_Y));
#pragma unroll
    for (int ai = 0; ai < 2; ++ai)
#pragma unroll
      for (int m = 0; m < 4; ++m) {
        const int row = u.pm * 256 + ai * 128 + wr * 64 + m * 16 + fr;
#pragma unroll
        for (int bj = 0; bj < 2; ++bj) {
          const int col = u.pn * 256 + bj * 128 + wc * 32 + fq * 8;
          const u32x2 a0 = pack4(acc[ai][bj][m][0]), a1 = pack4(acc[ai][bj][m][1]);
          *(u32x4*)(P + (size_t)row * 1024 + col) = (u32x4){a0.x, a0.y, a1.x, a1.y};
        }
      }
  }
};
struct EpiG4 {
  static constexpr bool PERM = true, AFTER_DRAIN = false;
  char* ws; int wbase;
  __device__ __forceinline__ void operator()(const AccT& acc, const pg8::Unit& u, int, int, int, int) const {
    int lane_ = lane_id(), wv_ = wbase; asm volatile("" : "+v"(lane_), "+s"(wv_));
    const int fr = lane_ & 15, fq = lane_ >> 4, wr = wv_ >> 8, wc = (wv_ >> 6) & 3;
    bf16_t* HID = (bf16_t*)(opq(ws) + OFF_HID);
#pragma unroll
    for (int ai = 0; ai < 2; ++ai)
#pragma unroll
      for (int m = 0; m < 4; ++m) {
        const int row = u.pm * 256 + ai * 128 + wr * 64 + m * 16 + fr;
#pragma unroll
        for (int bj = 0; bj < 2; ++bj) {
          const int col = u.pn * 256 + bj * 128 + wc * 32 + fq * 8;
          f32x4 v0 = acc[ai][bj][m][0], v1 = acc[ai][bj][m][1];
#pragma unroll
          for (int j = 0; j < 4; ++j) { const float r0 = fmaxf(v0[j], 0.f), r1 = fmaxf(v1[j], 0.f); v0[j] = r0 * r0; v1[j] = r1 * r1; }
          const u32x2 a0 = pack4(v0), a1 = pack4(v1);
          *(u32x4*)(HID + (size_t)row * 4096 + col) = (u32x4){a0.x, a0.y, a1.x, a1.y};
        }
      }
  }
};

__device__ void job_mod(const Params& p, int wb, int j, char* lds) {
  const int tid = otid();
  const int l = j / 96, chunk = j % 96;
  float* sil = (float*)lds;
  float* red = (float*)(lds + 20480);
  for (int i = tid; i < 5 * 1024; i += NTHR) {
    const int g = i >> 10, k = i & 1023;
    const float cv = (g == 0) ? p.c_ctx[k] : p.c[(g - 1) * 1024 + k];
    sil[i] = cv / (1.f + expf(-cv));
  }
  __syncthreads();
  const int cg4 = tid & 15, kg = tid >> 4;
  f32x4 acc[5];
#pragma unroll
  for (int g = 0; g < 5; ++g) acc[g] = (f32x4){0.f, 0.f, 0.f, 0.f};
  const float* w = p.w_mod + (size_t)l * 1024 * 6144 + chunk * 64 + cg4 * 4;
#pragma unroll 1
  for (int k0 = 0; k0 < 32; k0 += 8) {
    f32x4 wv[8];
#pragma unroll
    for (int e = 0; e < 8; ++e) wv[e] = *(const f32x4*)(w + (size_t)(kg * 32 + k0 + e) * 6144);
#pragma unroll
    for (int e = 0; e < 8; ++e)
#pragma unroll
      for (int g = 0; g < 5; ++g) acc[g] += wv[e] * sil[g * 1024 + kg * 32 + k0 + e];
  }
#pragma unroll
  for (int g = 0; g < 5; ++g) *(f32x4*)(red + (kg * 5 + g) * 64 + cg4 * 4) = acc[g];
  __syncthreads();
  float* MOD = (float*)(WS(p) + OFF_MOD);
  if (tid < 320) {
    const int g = tid >> 6, cc = tid & 63;
    float s = p.b_mod[l * 6144 + chunk * 64 + cc];
    for (int q = 0; q < 32; ++q) s += red[(q * 5 + g) * 64 + cc];
    MOD[(l * 5 + g) * 6144 + chunk * 64 + cc] = s;
  }
  __syncthreads();
}
__device__ void job_rope(const Params& p, int wb) {
  float* cosT = (float*)(WS(p) + OFF_ROPE);
  float* sinT = cosT + 1024;
  for (int t = otid(); t < 1024; t += NTHR) {
    const int pos = t >> 4, i = t & 15;
    const float inv = exp2f(-(float)i * (13.287712379549449f / 16.f));
    const float a = (float)pos * inv;
    cosT[t] = cosf(a); sinT[t] = sinf(a);
  }
}
__device__ void job_cache(const Params& p, int wb, int j) {
  const float* src; bf16_t* dst; int jj;
  if (j < 256) { src = p.cache_diff_k; dst = (bf16_t*)(WS(p) + OFF_CDK); jj = j; }
  else if (j < 512) { src = p.cache_diff_v; dst = (bf16_t*)(WS(p) + OFF_CDV); jj = j - 256; }
  else if (j < 576) { src = p.cache_win_k; dst = (bf16_t*)(WS(p) + OFF_CWK); jj = j - 512; }
  else { src = p.cache_win_v; dst = (bf16_t*)(WS(p) + OFF_CWV); jj = j - 576; }
  const size_t e = (size_t)jj * 4096 + otid() * 8;
  const f32x4 a = *(const f32x4*)(src + e), b = *(const f32x4*)(src + e + 4);
  u32x4 o; o.x = cvtpk(a[0], a[1]); o.y = cvtpk(a[2], a[3]); o.z = cvtpk(b[0], b[1]); o.w = cvtpk(b[2], b[3]);
  *(u32x4*)(dst + e) = o;
}
struct TileJob { const float* src; bf16_t* dst; int K, N, k0, n0; };
__device__ __forceinline__ TileJob tile_job(const Params& p, int l, int r) {
  TileJob t;
  if (r < 240) { t.src = p.w_in + (size_t)l * 1024 * 3840; t.K = 1024; t.N = 3840; t.dst = (bf16_t*)(WS(p) + OFF_WCAT + l * SZ_WCAT); }
  else if ((r -= 240) < 192) { t.src = p.w_gate + (size_t)l * 1024 * 3072; t.K = 1024; t.N = 3072; t.dst = (bf16_t*)(WS(p) + OFF_WCAT + l * SZ_WCAT) + (size_t)3840 * 1024; }
  else if ((r -= 192) < 32) { t.src = p.w_pa + (size_t)l * 512 * 1024; t.K = 512; t.N = 1024; t.dst = (bf16_t*)(WS(p) + OFF_WP + l * SZ_WP); }
  else if ((r -= 32) < 32) { t.src = p.w_pb + (size_t)l * 512 * 1024; t.K = 512; t.N = 1024; t.dst = (bf16_t*)(WS(p) + OFF_WP + l * SZ_WP) + (size_t)1024 * 512; }
  else if ((r -= 32) < 32) { t.src = p.w_pc + (size_t)l * 512 * 1024; t.K = 512; t.N = 1024; t.dst = (bf16_t*)(WS(p) + OFF_WP + l * SZ_WP) + (size_t)2 * 1024 * 512; }
  else if ((r -= 32) < 64) { t.src = p.w_o + (size_t)l * 1024 * 1024; t.K = 1024; t.N = 1024; t.dst = (bf16_t*)(WS(p) + OFF_WO + l * SZ_WO); }
  else if ((r -= 64) < 256) { t.src = p.w_ff1 + (size_t)l * 1024 * 4096; t.K = 1024; t.N = 4096; t.dst = (bf16_t*)(WS(p) + OFF_WF1 + l * SZ_WF); }
  else { r -= 256; t.src = p.w_ff2 + (size_t)l * 4096 * 1024; t.K = 4096; t.N = 1024; t.dst = (bf16_t*)(WS(p) + OFF_WF2 + l * SZ_WF); }
  const int ntn = t.N >> 7;
  t.k0 = (r / ntn) * 128; t.n0 = (r % ntn) * 128;
  return t;
}
__device__ __forceinline__ void tile_load(const TileJob& t, f32x4 (&v)[8], int tid) {
#pragma unroll
  for (int i = 0; i < 8; ++i) v[i] = *(const f32x4*)(t.src + (size_t)(t.k0 + (tid >> 5) + 16 * i) * t.N + t.n0 + (tid & 31) * 4);
}
__device__ __forceinline__ void tile_to_lds(const f32x4 (&v)[8], float* tile, int tid) {
#pragma unroll
  for (int i = 0; i < 8; ++i) {
    const int k = (tid >> 5) + 16 * i, n4 = (tid & 31) * 4;
    const int kb = k * 129 + (k >> 5) * 8;
    tile[kb + n4 + 0] = v[i][0]; tile[kb + n4 + 1] = v[i][1]; tile[kb + n4 + 2] = v[i][2]; tile[kb + n4 + 3] = v[i][3];
  }
}
__device__ __forceinline__ void tile_store(const TileJob& t, const float* tile, int tid) {
  const int n = tid >> 2, kc = (tid & 3) * 32, sk = (tid & 3) * 8;
  bf16_t* d = t.dst + (size_t)(t.n0 + n) * t.K + t.k0 + kc;
#pragma unroll
  for (int q = 0; q < 4; ++q) {
    u32x4 o;
    o.x = cvtpk(tile[(kc + q * 8 + 0) * 129 + sk + n], tile[(kc + q * 8 + 1) * 129 + sk + n]); o.y = cvtpk(tile[(kc + q * 8 + 2) * 129 + sk + n], tile[(kc + q * 8 + 3) * 129 + sk + n]);
    o.z = cvtpk(tile[(kc + q * 8 + 4) * 129 + sk + n], tile[(kc + q * 8 + 5) * 129 + sk + n]); o.w = cvtpk(tile[(kc + q * 8 + 6) * 129 + sk + n], tile[(kc + q * 8 + 7) * 129 + sk + n]);
    *(u32x4*)(d + q * 8) = o;
  }
}
__device__ void convert_tile(const Params& p, int wb, int l, int r, char* lds) {
  const int tid = otid();
  const TileJob t = tile_job(p, l, r);
  f32x4 v[8];
  tile_load(t, v, tid);
  tile_to_lds(v, (float*)lds, tid);
  __syncthreads();
  tile_store(t, (const float*)lds, tid);
  __syncthreads();
}
constexpr int NJ_MOD = 192, NJ_ROPE = 1, NJ_CACHE = 640, NJ_TR0 = 592;
constexpr int NJ_TOTAL = NJ_MOD + NJ_ROPE + NJ_CACHE + NJ_TR0;
__device__ void phase0(const Params& p, int wb, char* lds) {
  const int b = (int)blockIdx.x;
  if (b < NJ_MOD) job_mod(p, wb, b, lds);
  else if (b == NJ_MOD) job_rope(p, wb);
  constexpr int NREST = NJ_CACHE + NJ_TR0;
  for (int s = b; s < 320; s += (b < NJ_MOD ? 320 : 64))
    for (int r = s; r < NREST; r += 320) {
      if (r < NJ_CACHE) job_cache(p, wb, r);
      else convert_tile(p, wb, 0, r - NJ_CACHE, lds);
    }
}
constexpr int NJ_DEF = 512 + 1104, NJ_DEF_ITEMS = (NJ_DEF + 3) / 4;
__device__ __forceinline__ TileJob deferred_job(const Params& p, int j) { return j < 512 ? tile_job(p, 0, 592 + j) : tile_job(p, 1, j - 512); }
__device__ void deferred_convert(const Params& p, int wb, int j0, int j1, char* lds) {
  const int tid = otid();
  int j = j0;
  if (j >= j1) return;
  TileJob cur = deferred_job(p, j);
  f32x4 v[8];
  tile_load(cur, v, tid);
  for (;;) {
    tile_to_lds(v, (float*)lds, tid);
    __syncthreads();
    const int jn = j + 1;
    TileJob nxt = cur;
    if (jn < j1) { nxt = deferred_job(p, jn); tile_load(nxt, v, tid); }
    tile_store(cur, (const float*)lds, tid);
    __syncthreads();
    if (jn >= j1) break;
    cur = nxt; j = jn;
  }
}
__device__ void phase_h0(const Params& p, int wb) {
  const float* MOD = (const float*)(WS(p) + OFF_MOD);
  bf16_t* H = (bf16_t*)(WS(p) + OFF_H);
  for (int v = blockIdx.x * NTHR + otid(); v < 8192 * 128; v += gridDim.x * NTHR) {
    const int row = v >> 7, c8 = (v & 127) * 8;
    const float* x = (row < 4096 ? p.x_prompt + (size_t)row * 1024 : p.x_sample + (size_t)(row - 4096) * 1024) + c8;
    const float* md = MOD + row_group(row) * 6144;
    const f32x4 a = *(const f32x4*)x, b = *(const f32x4*)(x + 4);
    const f32x4 sh0 = *(const f32x4*)(md + c8), sh1 = *(const f32x4*)(md + c8 + 4);
    const f32x4 sc0 = *(const f32x4*)(md + 1024 + c8), sc1 = *(const f32x4*)(md + 1024 + c8 + 4);
    const f32x4 h0 = a * (sc0 + 1.f) + sh0, h1 = b * (sc1 + 1.f) + sh1;
    u32x4 o; o.x = cvtpk(h0[0], h0[1]); o.y = cvtpk(h0[2], h0[3]); o.z = cvtpk(h1[0], h1[1]); o.w = cvtpk(h1[2], h1[3]);
    *(u32x4*)(H + (size_t)row * 1024 + c8) = o;
  }
}

template <int KW> __device__ __forceinline__ int kaddr(int row, int ch) { return row * (KW * 2) + ((ch ^ (row & (KW / 8 - 1))) << 4); }
template <int DV> __device__ __forceinline__ int vaddr(int row, int boff) {
  if (DV == 128) return row * 256 + (boff ^ ((row & 7) << 5));
  return row * 128 + (boff ^ (((row >> 1) & 3) << 5));
}
template <int NMAPS, int DV>
__device__ __forceinline__ void attn_unit(int wbase, char* lds, const bf16_t* qp, int ldq,
                                          const bf16_t* K0, const bf16_t* V0, int ld0, int key0, int nt0,
                                          const bf16_t* K1, const bf16_t* V1, int ld1, int nt1,
                                          bool window, int qpos0, float m_init, float l_init,
                                          f32x4 (&o)[NMAPS][DV / 16], float (&lsum)[NMAPS]) {
  constexpr int KW = NMAPS * 64, NCHK = KW / 8, NKR = NCHK / 4, NVC = DV / 8, NVR = NVC / 4, KHB = 64 * KW * 2, VHB = 64 * DV * 2;
  const int tid = otid_w(wbase), lane = tid & 63, fr = lane & 15, fq = lane >> 4;
  bf16x8 qf[NMAPS][2];
#pragma unroll
  for (int mp = 0; mp < NMAPS; ++mp)
#pragma unroll
    for (int ks = 0; ks < 2; ++ks) qf[mp][ks] = *(const bf16x8*)(qp + (size_t)fr * ldq + mp * 64 + ks * 32 + fq * 8);
  float m[NMAPS], lr[NMAPS];
#pragma unroll
  for (int mp = 0; mp < NMAPS; ++mp) {
    m[mp] = m_init; lr[mp] = (fq == 0) ? l_init : 0.f;
#pragma unroll
    for (int c = 0; c < DV / 16; ++c) o[mp][c] = (f32x4){0.f, 0.f, 0.f, 0.f};
  }
  const int NT = nt0 + nt1;
  u32x4 kr[NKR], vr[NVR];
  auto load_tile = [&](int t) {
    const bf16_t* kp; const bf16_t* vp; int ld;
    if (t < nt0) { kp = K0 + (size_t)(key0 + t * 128) * ld0; vp = V0 + (size_t)(key0 + t * 128) * ld0; ld = ld0; }
    else { kp = K1 + (size_t)((t - nt0) * 128) * ld1; vp = V1 + (size_t)((t - nt0) * 128) * ld1; ld = ld1; }
#pragma unroll
    for (int i = 0; i < NKR; ++i) { const int idx = tid + NTHR * i, row = idx / NCHK, ch = idx % NCHK; kr[i] = *(const u32x4*)(kp + (size_t)row * ld + ch * 8); }
#pragma unroll
    for (int i = 0; i < NVR; ++i) { const int idx = tid + NTHR * i, row = idx / NVC, ch = idx % NVC; vr[i] = *(const u32x4*)(vp + (size_t)row * ld + ch * 8); }
  };
  load_tile(0);
  for (int t = 0; t < NT; ++t) {
    __syncthreads();
#pragma unroll
    for (int i = 0; i < NKR; ++i) { const int idx = tid + NTHR * i, row = idx / NCHK, ch = idx % NCHK; *(u32x4*)(lds + (row >> 6) * KHB + kaddr<KW>(row & 63, ch)) = kr[i]; }
#pragma unroll
    for (int i = 0; i < NVR; ++i) { const int idx = tid + NTHR * i, row = idx / NVC, ch = idx % NVC; *(u32x4*)(lds + 32768 + (row >> 6) * VHB + vaddr<DV>(row & 63, ch * 16)) = vr[i]; }
    __syncthreads();
    if (t + 1 < NT) load_tile(t + 1);
#pragma unroll
    for (int hf = 0; hf < 2; ++hf) {
      const char* kl = lds + hf * KHB;
      const char* vl = lds + 32768 + hf * VHB;
      bf16x8 pb[NMAPS][2];
#pragma unroll
      for (int mp = 0; mp < NMAPS; ++mp) {
        f32x4 s[4];
#pragma unroll
        for (int ksub = 0; ksub < 4; ++ksub) {
          s[ksub] = (f32x4){0.f, 0.f, 0.f, 0.f};
#pragma unroll
          for (int ks = 0; ks < 2; ++ks) {
            const bf16x8 kf = *(const bf16x8*)(kl + kaddr<KW>(ksub * 16 + fr, mp * 8 + ks * 4 + fq));
            s[ksub] = mfma16(kf, qf[mp][ks], s[ksub]);
          }
        }
        if (window && t < nt0) {
          const int qpos = qpos0 + fr, kb = key0 + t * 128 + hf * 64 + fq * 4;
#pragma unroll
          for (int ksub = 0; ksub < 4; ++ksub)
#pragma unroll
            for (int j = 0; j < 4; ++j) { const int d = kb + ksub * 16 + j - qpos; if (d > 128 || d < -128) s[ksub][j] = -1e30f; }
        }
        float mx = s[0][0];
#pragma unroll
        for (int ksub = 0; ksub < 4; ++ksub)
#pragma unroll
          for (int j = 0; j < 4; ++j) mx = fmaxf(mx, s[ksub][j]);
        mx = quad_max(mx);
        const float mnew = fmaxf(m[mp], mx * LOG2E);
        const float alpha = __builtin_amdgcn_exp2f(m[mp] - mnew);
        m[mp] = mnew;
        float ps = 0.f;
#pragma unroll
        for (int ksub = 0; ksub < 4; ++ksub)
#pragma unroll
          for (int j = 0; j < 4; ++j) { const float pv = __builtin_amdgcn_exp2f(s[ksub][j] * LOG2E - mnew); s[ksub][j] = pv; ps += pv; }
        lr[mp] = lr[mp] * alpha + ps;
        if (__any(alpha != 1.f)) {
#pragma unroll
          for (int c = 0; c < DV / 16; ++c) o[mp][c] *= alpha;
        }
#pragma unroll
        for (int kk = 0; kk < 2; ++kk) {
          u32x4 w; w.x = cvtpk(s[2 * kk][0], s[2 * kk][1]); w.y = cvtpk(s[2 * kk][2], s[2 * kk][3]);
          w.z = cvtpk(s[2 * kk + 1][0], s[2 * kk + 1][1]); w.w = cvtpk(s[2 * kk + 1][2], s[2 * kk + 1][3]);
          pb[mp][kk] = __builtin_bit_cast(bf16x8, w);
        }
      }
#pragma unroll
      for (int c = 0; c < DV / 16; ++c)
#pragma unroll
        for (int kk = 0; kk < 2; ++kk) {
          const int vrow = kk * 32 + fq * 4 + (fr >> 2), vb = (c * 16 + (lane & 3) * 4) * 2;
          const s16x4 lo = vtr(vl + vaddr<DV>(vrow, vb));
          const s16x4 hi = vtr(vl + vaddr<DV>(vrow + 16, vb));
          const bf16x8 vf = cat8(lo, hi);
#pragma unroll
          for (int mp = 0; mp < NMAPS; ++mp) o[mp][c] = mfma16(vf, pb[mp][kk], o[mp][c]);
        }
    }
  }
#pragma unroll
  for (int mp = 0; mp < NMAPS; ++mp) lsum[mp] = quad_sum(lr[mp]);
}

__device__ void unitA(const Params& p, int wb, int l, char* lds, int b_all, int h, int qb) {
  const bf16_t* Z = (const bf16_t*)(WS(p) + OFF_Z);
  const int tid = otid(), lane = tid & 63, wid = tid >> 6, fr = lane & 15, fq = lane >> 4;
  const bool lat = b_all >= 16; const int b = lat ? b_all - 16 : b_all;
  const int rowbase = lat ? 4096 + b * 1024 : b * 256;
  const int q0 = qb * 128 + wid * 16;
  const bf16_t* qp = Z + (size_t)(rowbase + q0) * 3840 + h * 128;
  const bf16_t* K0 = Z + (size_t)rowbase * 3840 + 512 + h * 128;
  const bf16_t* V0 = Z + (size_t)rowbase * 3840 + 1024 + h * 128;
  const bf16_t* K1 = (const bf16_t*)(WS(p) + OFF_CDK) + (size_t)((b * 2 + l) * 256) * 512 + h * 128;
  const bf16_t* V1 = (const bf16_t*)(WS(p) + OFF_CDV) + (size_t)((b * 2 + l) * 256) * 512 + h * 128;
  f32x4 o[2][8]; float ls[2];
  attn_unit<2, 128>(wb, lds, qp, 3840, K0, V0, 3840, 0, lat ? 8 : 2, K1, V1, 512, lat ? 2 : 0, false, 0, -1e30f, 0.f, o, ls);
  const float* lv = p.diff_lam + l * 256;
  const float d1 = wave_sum(lv[lane] * lv[64 + lane]), d2 = wave_sum(lv[128 + lane] * lv[192 + lane]);
  const float lam_init = p.lam_init[l];
  const float lam = expf(d1) - expf(d2) + lam_init;
  const float i0 = 1.f / ls[0], i1 = lam / ls[1];
  float ss = 0.f;
#pragma unroll
  for (int c = 0; c < 8; ++c) {
    o[0][c] = o[0][c] * i0 - o[1][c] * i1;
#pragma unroll
    for (int j = 0; j < 4; ++j) ss += o[0][c][j] * o[0][c][j];
  }
  ss = quad_sum(ss);
  const float r = rsqrtf(ss * (1.f / 128.f) + LN_EPS) * (1.f - lam_init);
  bf16_t* OA = (bf16_t*)(WS(p) + OFF_OA) + (size_t)(rowbase + q0 + fr) * 512 + h * 128 + fq * 4;
  const float* gn = p.diff_norm_g + l * 128 + fq * 4;
#pragma unroll
  for (int c = 0; c < 8; ++c) { const f32x4 g = *(const f32x4*)(gn + c * 16); *(u32x2*)(OA + c * 16) = pack4(o[0][c] * g * r); }
}
__device__ void unitB(const Params& p, int wb, int l, char* lds, int b_all, int kvh, int qb) {
  const bf16_t* Z = (const bf16_t*)(WS(p) + OFF_Z);
  const int tid = otid(), lane = tid & 63, wid = tid >> 6, fr = lane & 15, fq = lane >> 4;
  const bool lat = b_all >= 16; const int b = lat ? b_all - 16 : b_all;
  const int rowbase = lat ? 4096 + b * 1024 : b * 256;
  const int q0b = qb * 32, q0 = q0b + (wid >> 2) * 16, head = kvh * 4 + (wid & 3);
  const bf16_t* qp = Z + (size_t)(rowbase + q0) * 3840 + 1536 + head * 64;
  const bf16_t* K0 = Z + (size_t)rowbase * 3840 + 2048 + kvh * 64;
  const bf16_t* V0 = Z + (size_t)rowbase * 3840 + 2176 + kvh * 64;
  const bf16_t* K1 = (const bf16_t*)(WS(p) + OFF_CWK) + (size_t)((b * 2 + l) * 256) * 128 + kvh * 64;
  const bf16_t* V1 = (const bf16_t*)(WS(p) + OFF_CWV) + (size_t)((b * 2 + l) * 256) * 128 + kvh * 64;
  int key0 = 0, nt0 = 2, nt1 = 0;
  if (lat) {
    const int lo = q0b - 128 < 0 ? 0 : q0b - 128, hi = q0b + 159 > 1023 ? 1023 : q0b + 159;
    key0 = (lo >> 7) << 7; nt0 = (hi >> 7) - (lo >> 7) + 1; nt1 = 2;
  }
  const float sink = p.win_sink[l * 8 + head];
  f32x4 o[1][4]; float ls[1];
  attn_unit<1, 64>(wb, lds, qp, 3840, K0, V0, 3840, key0, nt0, K1, V1, 128, nt1, lat, q0, sink * LOG2E, 1.f, o, ls);
  const float inv = 1.f / ls[0];
  bf16_t* OB = (bf16_t*)(WS(p) + OFF_OB) + (size_t)(rowbase + q0 + fr) * 512 + head * 64 + fq * 4;
#pragma unroll
  for (int c = 0; c < 4; ++c) *(u32x2*)(OB + c * 16) = pack4(o[0][c] * inv);
}

__device__ void unitC(const Params& p, int wb, int l, char* lds, int b_all, int h, int dir) {
  const bf16_t* Z = (const bf16_t*)(WS(p) + OFF_Z);
  float* YF = (float*)(WS(p) + (dir ? OFF_YB : OFF_MRG));
  const int tid = otid(), lane = tid & 63, fr = lane & 15, fq = lane >> 4;
  const int wave = __builtin_amdgcn_readfirstlane(tid >> 6);
  const bool lat = b_all >= 16; const int b = lat ? b_all - 16 : b_all;
  const int rowbase = lat ? 4096 + b * 1024 : b * 256, nc = lat ? 8 : 2;
  {
    const float xd = p.ret_decay[(l * 2 + dir) * 4 + h];
    const float lg2 = -log2f(1.f + expf(-xd));
    const float g128 = exp2f(128.f * lg2);
    f32x4 st[4];
    if (lat) {
      const float* s0 = p.state_ret + (size_t)((((b * 2 + l) * 2 + dir) * 4 + h)) * 8192;
#pragma unroll
      for (int bb = 0; bb < 4; ++bb) st[bb] = *(const f32x4*)(s0 + (bb * 16 + fr) * 128 + wave * 16 + fq * 4);
    } else {
#pragma unroll
      for (int bb = 0; bb < 4; ++bb) st[bb] = (f32x4){0.f, 0.f, 0.f, 0.f};
    }
    u32x4 kzr[2], vr4[4];
    auto load_chunk = [&](int cc_) {
      const int rr = rowbase + (dir ? nc - 1 - cc_ : cc_) * 128;
#pragma unroll
      for (int i = 0; i < 2; ++i) { const int idx = tid + NTHR * i, row = idx >> 3, ch = idx & 7; kzr[i] = *(const u32x4*)(Z + (size_t)(rr + row) * 3840 + 2560 + h * 64 + ch * 8); }
#pragma unroll
      for (int i = 0; i < 4; ++i) { const int idx = tid + NTHR * i, row = idx >> 4, ch = idx & 15; vr4[i] = *(const u32x4*)(Z + (size_t)(rr + row) * 3840 + 2816 + h * 128 + ch * 8); }
    };
    load_chunk(0);
#pragma unroll 1
    for (int cc = 0; cc < nc; ++cc) {
      const int c = dir ? nc - 1 - cc : cc;
      const int r0 = rowbase + c * 128;
      __syncthreads();
#pragma unroll
      for (int bb = 0; bb < 4; ++bb) {
        st[bb] *= g128;
        *(u32x2*)(lds + 16384 + vaddr<128>(bb * 16 + fr, (wave * 16 + fq * 4) * 2)) = pack4(st[bb]);
      }
#pragma unroll
      for (int i = 0; i < 2; ++i) {
        const int idx = tid + NTHR * i, row = idx >> 3, ch = idx & 7;
        const u32x4 v = kzr[i];
        const float zeta = exp2f(lg2 * (float)(dir ? row : 127 - row));
        u32x4 w;
        w.x = cvtpk(bflo(v.x) * zeta, bfhi(v.x) * zeta); w.y = cvtpk(bflo(v.y) * zeta, bfhi(v.y) * zeta);
        w.z = cvtpk(bflo(v.z) * zeta, bfhi(v.z) * zeta); w.w = cvtpk(bflo(v.w) * zeta, bfhi(v.w) * zeta);
        *(u32x4*)(lds + row * 128 + ((ch ^ (row & 7)) << 4)) = w;
      }
#pragma unroll
      for (int i = 0; i < 4; ++i) {
        const int idx = tid + NTHR * i, row = idx >> 4, ch = idx & 15;
        *(u32x4*)(lds + 32768 + vaddr<128>(row, ch * 16)) = vr4[i];
      }
      __syncthreads();
      if (cc + 1 < nc) load_chunk(cc + 1);
      {
        const int qw0 = wave * 16;
        const bf16_t* qbase = Z + (size_t)(r0 + qw0 + fr) * 3840 + 2304 + h * 64;
        f32x4 acc[8];
        {
          bf16x8 qx[2];
#pragma unroll
          for (int ks = 0; ks < 2; ++ks) {
            const u32x2 lo = *(const u32x2*)(qbase + ks * 32 + fq * 4);
            const u32x2 hi = *(const u32x2*)(qbase + ks * 32 + 16 + fq * 4);
            u32x4 w; w.x = lo.x; w.y = lo.y; w.z = hi.x; w.w = hi.y;
            qx[ks] = __builtin_bit_cast(bf16x8, w);
          }
#pragma unroll
          for (int c8 = 0; c8 < 8; ++c8) {
            acc[c8] = (f32x4){0.f, 0.f, 0.f, 0.f};
#pragma unroll
            for (int ks = 0; ks < 2; ++ks) {
              const int srow = ks * 32 + fq * 4 + (fr >> 2), sb = (c8 * 16 + (lane & 3) * 4) * 2;
              const bf16x8 sf = cat8(vtr(lds + 16384 + vaddr<128>(srow, sb)), vtr(lds + 16384 + vaddr<128>(srow + 16, sb)));
              acc[c8] = mfma16(sf, qx[ks], acc[c8]);
            }
          }
        }
        bf16x8 qf[2];
#pragma unroll
        for (int ks = 0; ks < 2; ++ks) qf[ks] = *(const bf16x8*)(qbase + ks * 32 + fq * 8);
#pragma unroll
        for (int kk = 0; kk < 4; ++kk) {
          if (dir == 0 ? (kk * 32 > qw0 + 15) : (kk * 32 + 31 < qw0)) continue;
          f32x4 s0 = (f32x4){0.f, 0.f, 0.f, 0.f}, s1 = (f32x4){0.f, 0.f, 0.f, 0.f};
#pragma unroll
          for (int ks = 0; ks < 2; ++ks) {
            const int co = ((ks * 4 + fq) ^ (fr & 7)) << 4;
            const bf16x8 k0f = *(const bf16x8*)(lds + (kk * 32 + fr) * 128 + co);
            const bf16x8 k1f = *(const bf16x8*)(lds + (kk * 32 + 16 + fr) * 128 + co);
            s0 = mfma16(k0f, qf[ks], s0); s1 = mfma16(k1f, qf[ks], s1);
          }
          const int qtok = qw0 + fr, kt0 = kk * 32 + fq * 4;
#pragma unroll
          for (int j = 0; j < 4; ++j) {
            const int ka = kt0 + j, kb = kt0 + 16 + j;
            const bool keepa = dir == 0 ? (ka <= qtok) : (ka >= qtok);
            const bool keepb = dir == 0 ? (kb <= qtok) : (kb >= qtok);
            s0[j] = keepa ? s0[j] : 0.f; s1[j] = keepb ? s1[j] : 0.f;
          }
          u32x4 w; w.x = cvtpk(s0[0], s0[1]); w.y = cvtpk(s0[2], s0[3]); w.z = cvtpk(s1[0], s1[1]); w.w = cvtpk(s1[2], s1[3]);
          const bf16x8 pb = __builtin_bit_cast(bf16x8, w);
#pragma unroll
          for (int c8 = 0; c8 < 8; ++c8) {
            const int vrow = kk * 32 + fq * 4 + (fr >> 2), vb = (c8 * 16 + (lane & 3) * 4) * 2;
            const bf16x8 vf = cat8(vtr(lds + 32768 + vaddr<128>(vrow, vb)), vtr(lds + 32768 + vaddr<128>(vrow + 16, vb)));
            acc[c8] = mfma16(vf, pb, acc[c8]);
          }
        }
        {
          const int qtok = qw0 + fr;
          const float rowfac = exp2f(lg2 * (float)(dir ? -qtok : qtok - 127));
          const int row = r0 + qtok;
          float* yp = YF + (size_t)row * 512 + h * 128 + fq * 4;
#pragma unroll
          for (int c8 = 0; c8 < 8; ++c8) *(f32x4*)(yp + c8 * 16) = acc[c8] * rowfac;
        }
      }
#pragma unroll
      for (int kk = 0; kk < 4; ++kk) {
        const int trow = kk * 32 + fq * 4 + (fr >> 2);
        bf16x8 kz[4];
#pragma unroll
        for (int bb = 0; bb < 4; ++bb) {
          const int col = bb * 16 + (lane & 3) * 4;
          const s16x4 lo = vtr(lds + trow * 128 + (((col >> 3) ^ (trow & 7)) << 4) + (col & 7) * 2);
          const s16x4 hi = vtr(lds + (trow + 16) * 128 + (((col >> 3) ^ (trow & 7)) << 4) + (col & 7) * 2);
          kz[bb] = cat8(lo, hi);
        }
        const int vb = (wave * 16 + (lane & 3) * 4) * 2;
        const bf16x8 vt = cat8(vtr(lds + 32768 + vaddr<128>(trow, vb)), vtr(lds + 32768 + vaddr<128>(trow + 16, vb)));
#pragma unroll
        for (int bb = 0; bb < 4; ++bb) st[bb] = mfma16(vt, kz[bb], st[bb]);
      }
    }
    if (!lat) {
      float* dst = OUTP(p) + OUT_ST + (size_t)((((b * 2 + l) * 2 + dir) * 4 + h)) * 8192;
#pragma unroll
      for (int bb = 0; bb < 4; ++bb) *(f32x4*)(dst + (bb * 16 + fr) * 128 + wave * 16 + fq * 4) = st[bb];
    }
  }
  asm volatile("s_waitcnt vmcnt(0)" ::: "memory");
  __syncthreads();
  if (tid == 0) {
    __builtin_amdgcn_fence(__ATOMIC_RELEASE, "agent");
    asm volatile("s_waitcnt vmcnt(0)" ::: "memory");
    (void)__hip_atomic_fetch_add((unsigned*)(WS(p) + OFF_CNT) + 64 + (l * 20 + b_all) * 4 + h, 1u, __ATOMIC_RELAXED, __HIP_MEMORY_SCOPE_AGENT);
  }
}
__device__ void unitCF(const Params& p, int wb, int l, char* lds, int b_all, int h, int tb) {
  const int tid = otid(), lane = tid & 63, wid = tid >> 6;
  if (tid == 0) {
    unsigned* dn = (unsigned*)(WS(p) + OFF_CNT) + 64 + (l * 20 + b_all) * 4 + h;
    unsigned sp = 0;
    while (__hip_atomic_load(dn, __ATOMIC_RELAXED, __HIP_MEMORY_SCOPE_AGENT) < 2u) { __builtin_amdgcn_s_sleep(2); if (++sp > (1u << 22)) break; }
    __builtin_amdgcn_fence(__ATOMIC_ACQUIRE, "agent");
    asm volatile("s_waitcnt vmcnt(0)" ::: "memory");
  }
  __syncthreads();
  const bf16_t* Z = (const bf16_t*)(WS(p) + OFF_Z);
  const float* YF = (const float*)(WS(p) + OFF_MRG);
  const float* YB = (const float*)(WS(p) + OFF_YB);
  bf16_t* OC = (bf16_t*)(WS(p) + OFF_OC);
  const bool lat = b_all >= 16; const int b = lat ? b_all - 16 : b_all;
  const int row0 = (lat ? 4096 + b * 1024 : b * 256) + tb * 256 + wid * 32;
  const int sub = lane >> 4, l16 = lane & 15;
  const f32x4 g0 = *(const f32x4*)(p.ret_norm_g + l * 128 + l16 * 8), g1 = *(const f32x4*)(p.ret_norm_g + l * 128 + l16 * 8 + 4);
#pragma unroll 2
  for (int i = 0; i < 8; ++i) {
    const int row = row0 + i * 4 + sub;
    const size_t ro = (size_t)row * 512 + h * 128 + l16 * 8;
    f32x4 a0 = *(const f32x4*)(YF + ro) + *(const f32x4*)(YB + ro), a1 = *(const f32x4*)(YF + ro + 4) + *(const f32x4*)(YB + ro + 4);
    const u32x4 cgw = *(const u32x4*)(Z + (size_t)row * 3840 + 3328 + h * 128 + l16 * 8);
    float s = ((a0[0] + a0[1]) + (a0[2] + a0[3])) + ((a1[0] + a1[1]) + (a1[2] + a1[3]));
    s += __shfl_xor(s, 8); s += __shfl_xor(s, 4); s += __shfl_xor(s, 2); s += __shfl_xor(s, 1);
    const float mu = s * (1.f / 128.f);
    a0 = a0 - mu; a1 = a1 - mu;
    float q = ((a0[0] * a0[0] + a0[1] * a0[1]) + (a0[2] * a0[2] + a0[3] * a0[3])) + ((a1[0] * a1[0] + a1[1] * a1[1]) + (a1[2] * a1[2] + a1[3] * a1[3]));
    q += __shfl_xor(q, 8); q += __shfl_xor(q, 4); q += __shfl_xor(q, 2); q += __shfl_xor(q, 1);
    const float rstd = rsqrtf(q * (1.f / 128.f) + LN_EPS);
    f32x4 c0 = unpack4((u32x2){cgw.x, cgw.y}), c1 = unpack4((u32x2){cgw.z, cgw.w});
#pragma unroll
    for (int j = 0; j < 4; ++j) { c0[j] = c0[j] * __builtin_amdgcn_rcpf(1.f + __expf(-c0[j])); c1[j] = c1[j] * __builtin_amdgcn_rcpf(1.f + __expf(-c1[j])); }
    const u32x2 o0 = pack4(a0 * rstd * g0 * c0), o1 = pack4(a1 * rstd * g1 * c1);
    *(u32x4*)(OC + ro) = (u32x4){o0.x, o0.y, o1.x, o1.y};
  }
}


#define PG8_FLAGS true, true
__device__ void phase_att(const Params& p, int wb, int l, char* lds, LAS unsigned char* ldsg) {
  unsigned* cnt = (unsigned*)(WS(p) + OFF_CNT) + l;
  for (;;) {
    __syncthreads();
    if (otid() == 0) *(int*)(lds + LDS_FLAG) = (int)atomicAdd(cnt, 1u);
    __syncthreads();
    const int u = __builtin_amdgcn_readfirstlane(*(const int*)(lds + LDS_FLAG));
    if (u >= 1152) break;
    if (u < 32) unitC(p, wb, l, lds, 16 + (u >> 3), (u >> 1) & 3, u & 1);
    else if (u < 160) { const int v = u - 32; unitA(p, wb, l, lds, 16 + (v >> 5), (v >> 3) & 3, v & 7); }
    else if (u < 256) {
      pg8::Gemm g{(const bf16_t*)(WS(p) + OFF_H), (const bf16_t*)(WS(p) + OFF_WCAT + l * SZ_WCAT), 1024, 1024};
      SchedG1 SG; SG.sz.init(8192, 3840, (int)gridDim.x, 0, 16); SG.sg.init(8192, 3072, (int)gridDim.x, 0, 16);
      SchedOne S1; SG.at(768 + (u - 160), S1.u0);
      EpiSplit<EpiG1, false, 1> E{EpiG1{p.ws, p.b_gate, p.out, l}, p.ws, OFF_OA, 256 + l * 1024, ldsg, wb};
      pg8::gemm_phase<EpiSplit<EpiG1, false, 1>, SchedOne, PG8_FLAGS>(ldsg, g, S1, E, wb);
    }
    else if (u < 384) { const int v = u - 256; unitC(p, wb, l, lds, v >> 3, (v >> 1) & 3, v & 1); }
    else if (u < 512) { const int v = u - 384; unitA(p, wb, l, lds, v >> 3, (v >> 1) & 3, v & 1); }
    else if (u < 768) { const int v = u - 512; unitB(p, wb, l, lds, 16 + (v >> 6), (v >> 5) & 1, v & 31); }
    else if (u < 1024) { const int v = u - 768; unitB(p, wb, l, lds, v >> 4, (v >> 3) & 1, v & 7); }
    else if (u < 1088) { const int v = u - 1024; unitCF(p, wb, l, lds, 16 + (v >> 4), (v >> 2) & 3, v & 3); }
    else { const int v = u - 1088; unitCF(p, wb, l, lds, v >> 2, v & 3, 0); }
  }
}

template <bool COMBINE, int NR>
__device__ void ln_rows(const Params& p, int wb, int row_lo, int row_hi, const float* Y, const float* P1, const float* gate, const float* g, const float* bta, const float* md, int sh_off, int sc_off) {
  float* X = OUTP(p) + OUT_X;
  bf16_t* H = (bf16_t*)(WS(p) + OFF_H);
  const int tid = otid(), lane = tid & 63, wid = tid >> 6;
  for (int row0 = row_lo + wid * NR; row0 < row_hi; row0 += 8 * NR) {
    f32x4 v[NR][4];
    if (!COMBINE) {
#pragma unroll
      for (int r = 0; r < NR; ++r)
#pragma unroll
        for (int k = 0; k < 2; ++k) {
          const u32x4 w = *(const u32x4*)((const bf16_t*)Y + (size_t)(row0 + r) * 1024 + k * 512 + lane * 8);
          v[r][2 * k] = unpack4((u32x2){w.x, w.y}); v[r][2 * k + 1] = unpack4((u32x2){w.z, w.w});
        }
    } else {
      const bf16_t* Yb = (const bf16_t*)Y; const bf16_t* Pb = (const bf16_t*)P1;
#pragma unroll
      for (int r = 0; r < NR; ++r)
#pragma unroll
        for (int k = 0; k < 2; ++k) {
          const int cb = k * 512 + lane * 8;
          const u32x4 w0 = *(const u32x4*)(Yb + (size_t)(row0 + r) * 1024 + cb), w1 = *(const u32x4*)(Pb + (size_t)(row0 + r) * 1024 + cb);
          const f32x4 fa = unpack4((u32x2){w0.x, w0.y}) + unpack4((u32x2){w1.x, w1.y}), fb = unpack4((u32x2){w0.z, w0.w}) + unpack4((u32x2){w1.z, w1.w});
          const float* xr = X + (size_t)(row0 + r) * 1024 + cb; const float* gr = gate + row_group(row0 + r) * 6144 + cb;
          v[r][2 * k] = *(const f32x4*)xr * ALPHA_RES + *(const f32x4*)gr * fa;
          v[r][2 * k + 1] = *(const f32x4*)(xr + 4) * ALPHA_RES + *(const f32x4*)(gr + 4) * fb;
        }
    }
#pragma unroll
    for (int r = 0; r < NR; ++r) {
      const int row = row0 + r;
      float s = 0.f;
#pragma unroll
      for (int i = 0; i < 4; ++i) s += (v[r][i][0] + v[r][i][1]) + (v[r][i][2] + v[r][i][3]);
      const float mu = wave_sum(s) * (1.f / 1024.f);
      float q = 0.f;
#pragma unroll
      for (int i = 0; i < 4; ++i) { v[r][i] = v[r][i] - mu; q += (v[r][i][0] * v[r][i][0] + v[r][i][1] * v[r][i][1]) + (v[r][i][2] * v[r][i][2] + v[r][i][3] * v[r][i][3]); }
      const float rstd = rsqrtf(wave_sum(q) * (1.f / 1024.f) + LN_EPS);
      const float* mrow = md ? md + row_group(row) * 6144 : nullptr;
#pragma unroll
      for (int k = 0; k < 2; ++k) {
        const int cb = k * 512 + lane * 8;
        const f32x4 x0 = v[r][2 * k] * rstd * *(const f32x4*)(g + cb) + *(const f32x4*)(bta + cb);
        const f32x4 x1 = v[r][2 * k + 1] * rstd * *(const f32x4*)(g + cb + 4) + *(const f32x4*)(bta + cb + 4);
        *(f32x4*)(X + (size_t)row * 1024 + cb) = x0; *(f32x4*)(X + (size_t)row * 1024 + cb + 4) = x1;
        if (mrow) {
          const f32x4 h0 = x0 * (*(const f32x4*)(mrow + sc_off + cb) + 1.f) + *(const f32x4*)(mrow + sh_off + cb);
          const f32x4 h1 = x1 * (*(const f32x4*)(mrow + sc_off + cb + 4) + 1.f) + *(const f32x4*)(mrow + sh_off + cb + 4);
          const u32x2 a0 = pack4(h0), a1 = pack4(h1);
          *(u32x4*)(H + (size_t)row * 1024 + cb) = (u32x4){a0.x, a0.y, a1.x, a1.y};
        }
      }
    }
  }
}
template <bool COMBINE, int NR>
__device__ void phase_ln(const Params& p, int wb, const float* Y, const float* P1, const float* gate, const float* g, const float* bta, const float* md, int sh_off, int sc_off) {
  const int rpb = 8192 / (int)gridDim.x;
  ln_rows<COMBINE, NR>(p, wb, (int)blockIdx.x * rpb, ((int)blockIdx.x + 1) * rpb, Y, P1, gate, g, bta, md, sh_off, sc_off);
}

#define XB_TMO      128
#define XB_XCNT(j)  (256  + 64 * (j))
#define XB_XSUB(j)  (1280 + 64 * (j))
#define XB_XGEN(j)  (2304 + 64 * (j))
#define XB_TOP      3328
#define XB_TOPGEN   3392
#define XCD_BAR_WORDS 3456
#define XB_SPIN_CAP (1u << 18)
__device__ __forceinline__ unsigned xb_ld(unsigned* p)              { return __hip_atomic_load(p, __ATOMIC_RELAXED, __HIP_MEMORY_SCOPE_AGENT); }
__device__ __forceinline__ unsigned xb_add(unsigned* p, unsigned v) { return __hip_atomic_fetch_add(p, v, __ATOMIC_RELAXED, __HIP_MEMORY_SCOPE_AGENT); }
__device__ __forceinline__ unsigned xb_xcc_id() { return (unsigned)__builtin_amdgcn_s_getreg((3 << 11) | 20) & 0xFu; }
#define XB_SPIN(cond, bar) do { unsigned _sp = 0; while (cond) { __builtin_amdgcn_s_sleep(1); \
    if ((++_sp & 255u) == 0u) { if (xb_ld(&(bar)[XB_TMO])) break; if (_sp > XB_SPIN_CAP) { atomicAdd(&(bar)[XB_TMO], 1u); break; } } } } while (0)
__device__ __forceinline__ void xcd_barrier_post(unsigned* bar, bool t0) { if (t0) (void)xb_add(&bar[XB_XCNT(xb_xcc_id())], 1u); }
__device__ __forceinline__ void xcd_barrier_complete(unsigned* bar, unsigned x, unsigned& nloc, unsigned& nx) {
    const unsigned G = gridDim.x * gridDim.y * gridDim.z;
    unsigned sum, cnt, mine, sp = 0u;
    for (;;) {
        sum = 0u; cnt = 0u; mine = 0u;
#pragma unroll
        for (unsigned j = 0; j < 16; ++j) { const unsigned c = xb_ld(&bar[XB_XCNT(j)]); sum += c; cnt += (c > 0u) ? 1u : 0u; mine = (j == x) ? c : mine; }
        if (sum == G) break;
        __builtin_amdgcn_s_sleep(1);
        if ((++sp & 255u) == 0u) { if (xb_ld(&bar[XB_TMO])) break; if (sp > XB_SPIN_CAP) { atomicAdd(&bar[XB_TMO], 1u); break; } }
    }
    nloc = mine > 0u ? mine : 1u; nx = cnt > 0u ? cnt : 1u;
}
__device__ __forceinline__ void xcd_barrier(unsigned* bar, volatile LAS unsigned* st, bool t0) {
    asm volatile("s_waitcnt vmcnt(0)" ::: "memory");
    __syncthreads();
    if (t0) {
        const unsigned x = xb_xcc_id();
        __builtin_amdgcn_s_waitcnt(0);
        unsigned nloc = st[0], nx = st[1];
        if (nloc == 0u) { xcd_barrier_complete(bar, x, nloc, nx); st[0] = nloc; st[1] = nx; }
        const unsigned old = xb_add(&bar[XB_XSUB(x)], 1u);
        const unsigned gen = old / nloc;
        if (old + 1u == (gen + 1u) * nloc) {
            __builtin_amdgcn_fence(__ATOMIC_RELEASE, "agent");
            asm volatile("s_waitcnt vmcnt(0)" ::: "memory");
            const unsigned og = xb_add(&bar[XB_TOP], 1u);
            const unsigned tg = og / nx;
            if (og + 1u == (tg + 1u) * nx) xb_add(&bar[XB_TOPGEN], 1u);
            else XB_SPIN(xb_ld(&bar[XB_TOPGEN]) == tg, bar);
            __builtin_amdgcn_fence(__ATOMIC_ACQUIRE, "agent");
            xb_add(&bar[XB_XGEN(x)], 1u);
            asm volatile("s_waitcnt vmcnt(0)" ::: "memory");
        } else {
            XB_SPIN(xb_ld(&bar[XB_XGEN(x)]) == gen, bar);
            __builtin_amdgcn_fence(__ATOMIC_ACQUIRE, "agent");
            asm volatile("s_waitcnt vmcnt(0)" ::: "memory");
        }
    }
    __syncthreads();
}
#define GRID_BAR() xcd_barrier((unsigned*)(WS(p) + OFF_BAR), (volatile LAS unsigned*)(ldsg + LDS_ST), otid() == 0)

__global__ void __launch_bounds__(NTHR, 2) fwd_megakernel(Params p) {
  const int wb = __builtin_amdgcn_readfirstlane((int)threadIdx.x) & ~63;
  cg::grid_group grid = cg::this_grid();
  extern __shared__ __attribute__((aligned(16))) unsigned char lds_dyn[];
  char* lds = (char*)lds_dyn;
  LAS unsigned char* ldsg = (LAS unsigned char*)lds_dyn;
  if (p.ws == nullptr) grid.sync();
  { const int t_ = otid(); if (t_ < 4) ((LAS unsigned*)(ldsg + LDS_ST))[t_] = 0u; __syncthreads(); xcd_barrier_post((unsigned*)(WS(p) + OFF_BAR), t_ == 0); }
  phase0(p, wb, lds);
  GRID_BAR();
  phase_h0(p, wb);
  GRID_BAR();
#pragma unroll 1
  for (int l = 0; l < 2; ++l) {
    {
      pg8::Gemm g{(const bf16_t*)(WS(p) + OFF_H), (const bf16_t*)(WS(p) + OFF_WCAT + l * SZ_WCAT), 1024, 1024};
      SchedG1 S; S.sz.init(8192, 3840, (int)gridDim.x, (int)blockIdx.x, 16); S.sg.init(8192, 3072, (int)gridDim.x, (int)blockIdx.x, 16);
      EpiSplit<EpiG1, false, 1> E{EpiG1{p.ws, p.b_gate, p.out, l}, p.ws, OFF_OA, 256 + l * 1024, ldsg, wb};
      pg8::gemm_phase<EpiSplit<EpiG1, false, 1>, SchedG1, PG8_FLAGS>(ldsg, g, S, E, wb);
    }
    GRID_BAR();
    phase_att(p, wb, l, lds, ldsg);
    GRID_BAR();
    {
      pg8::Gemm g{(const bf16_t*)(WS(p) + OFF_OA), (const bf16_t*)(WS(p) + OFF_WP + l * SZ_WP), 512, 512};
      SchedBr S; S.so.init(8192, 1024, (int)gridDim.x, (int)blockIdx.x, 8);
      EpiSplit<EpiG2, true, 2> E{EpiG2{p.ws}, p.ws, OFF_Z, 256 + l * 1024 + 256, ldsg, wb};
      pg8::gemm_phase<EpiSplit<EpiG2, true, 2>, SchedBr, PG8_FLAGS>(ldsg, g, S, E, wb);
      if (l == 0 && blockIdx.x >= 128) { const int i0 = ((int)blockIdx.x - 128) * 5; deferred_convert(p, wb, i0, i0 + 5, lds); }
    }
    GRID_BAR();
    {
      pg8::Gemm g{(const bf16_t*)(WS(p) + OFF_MRG), (const bf16_t*)(WS(p) + OFF_WO + l * SZ_WO), 1024, 1024};
      pg8::StaticOrder S; S.init(8192, 1024, (int)gridDim.x, (int)blockIdx.x, 16);
      const float* xc = l == 0 ? p.x_prompt : p.out + OUT_X;
      const float* xl = l == 0 ? p.x_sample : p.out + OUT_X + (size_t)4096 * 1024;
      EpiSplit<EpiG3, false, 1> E{EpiG3{p.ws, xc, xl, l, 2048}, p.ws, OFF_Z, 256 + l * 1024 + 512, ldsg, wb};
      pg8::gemm_phase<EpiSplit<EpiG3, false, 1>, pg8::StaticOrder, PG8_FLAGS>(ldsg, g, S, E, wb);
      if (l == 0 && blockIdx.x >= 128) { const int i0 = 640 + ((int)blockIdx.x - 128) * 8; deferred_convert(p, wb, i0, i0 + 8 < NJ_DEF ? i0 + 8 : NJ_DEF, lds); }
    }
    GRID_BAR();
    phase_ln<false, 4>(p, wb, (const float*)(WS(p) + OFF_Y), nullptr, nullptr, p.ln1_g + l * 1024, p.ln1_b + l * 1024, (const float*)(WS(p) + OFF_MOD) + l * 5 * 6144, 3072, 4096);
    GRID_BAR();
    {
      pg8::Gemm g{(const bf16_t*)(WS(p) + OFF_H), (const bf16_t*)(WS(p) + OFF_WF1 + l * SZ_WF), 1024, 1024};
      pg8::StaticOrder S; S.init(8192, 4096, (int)gridDim.x, (int)blockIdx.x, 16);
      EpiG4 E{p.ws, wb};
      pg8::gemm_phase<EpiG4, pg8::StaticOrder, PG8_FLAGS>(ldsg, g, S, E, wb);
    }
    GRID_BAR();
    {
      pg8::Gemm g{(const bf16_t*)(WS(p) + OFF_HID), (const bf16_t*)(WS(p) + OFF_WF2 + l * SZ_WF), 4096, 2048};
      SchedSplit2 S; S.so.init(8192, 1024, (int)gridDim.x, (int)blockIdx.x, 32); S.khalf_len = 2048; S.sn = 1;
      EpiSplit<EpiG5, false, 1> E{EpiG5{p.ws}, p.ws, OFF_Z, 256 + l * 1024 + 768, ldsg, wb};
      pg8::gemm_phase<EpiSplit<EpiG5, false, 1>, SchedSplit2, PG8_FLAGS>(ldsg, g, S, E, wb);
    }
    GRID_BAR();
    phase_ln<true, 4>(p, wb, (const float*)(WS(p) + OFF_Y), (const float*)(WS(p) + OFF_OA), (const float*)(WS(p) + OFF_MOD) + l * 5 * 6144 + 5120, p.ln2_g + l * 1024, p.ln2_b + l * 1024,
                   l == 0 ? (const float*)(WS(p) + OFF_MOD) + 5 * 6144 : nullptr, 0, 1024);
    GRID_BAR();
  }
}

extern "C" void kernel_launch(void* const* d_in, const int* in_sizes, int n_in, void* d_out, int out_size, void* d_ws, size_t ws_size, hipStream_t stream) {
  static int grid_blocks = 0;
  if (!grid_blocks) {
    int dev = 0, cus = 0, per_cu = 0;
    (void)hipGetDevice(&dev);
    (void)hipDeviceGetAttribute(&cus, hipDeviceAttributeMultiprocessorCount, dev);
    if (hipFuncSetAttribute((const void*)fwd_megakernel, hipFuncAttributeMaxDynamicSharedMemorySize, LDS_BYTES) != hipSuccess) fprintf(stderr, "hipFuncSetAttribute failed\n");
    (void)hipOccupancyMaxActiveBlocksPerMultiprocessor(&per_cu, fwd_megakernel, NTHR, LDS_BYTES);
    if (per_cu > 1) per_cu = 1;
    if (per_cu < 1) { fprintf(stderr, "occupancy query says 0 blocks per CU\n"); per_cu = 1; }
    grid_blocks = cus * per_cu;
  }
  if (ws_size < WS_NEED) { fprintf(stderr, "workspace too small: %zu < %zu\n", ws_size, (size_t)WS_NEED); return; }
  Params p{};
  const float** f = (const float**)&p;
  for (int i = 0; i < 29; ++i) f[i] = (const float*)d_in[i];
  p.out = (float*)d_out; p.ws = (char*)d_ws;
  p.lam_init[0] = (float)(0.8 - 0.6 * exp(-0.3 * 0.0));
  p.lam_init[1] = (float)(0.8 - 0.6 * exp(-0.3 * 1.0));
  (void)hipMemsetAsync((char*)d_ws + OFF_CNT, 0, OFF_YB - OFF_CNT, stream);
  void* args[] = {&p};
  hipError_t e = hipLaunchCooperativeKernel((void*)fwd_megakernel, dim3(grid_blocks), dim3(NTHR), args, LDS_BYTES, stream);
  if (e != hipSuccess) fprintf(stderr, "cooperative launch failed: %s (grid %d)\n", hipGetErrorString(e), grid_blocks);
}
```

```cpp
#include <hip/hip_runtime.h>
#include <hip/hip_cooperative_groups.h>
#include <cstdio>
#include <cstdint>
#include <cmath>
namespace cg = cooperative_groups;

typedef unsigned short bf16_t;
typedef short bf16x8 __attribute__((ext_vector_type(8)));
typedef float f32x4 __attribute__((ext_vector_type(4)));
typedef unsigned u32x4 __attribute__((ext_vector_type(4)));
typedef unsigned u32x2 __attribute__((ext_vector_type(2)));
typedef short s16x4 __attribute__((ext_vector_type(4)));
typedef __bf16 bf16x2_t __attribute__((ext_vector_type(2)));
typedef float f32x2_t __attribute__((ext_vector_type(2)));
typedef __attribute__((address_space(3))) s16x4* lds_s16x4_ptr;
#define LAS __attribute__((address_space(3)))

#define LOG2E 1.4426950408889634f
#define ALPHA_RES 1.4142135623730951f
#define LN_EPS 1e-5f

constexpr size_t SZ_WCAT = 6912ull * 1024 * 2, SZ_WP = 3ull * 1024 * 512 * 2, SZ_WO = 1024ull * 1024 * 2, SZ_WF = 4096ull * 1024 * 2;
constexpr size_t OFF_WCAT = 0;
constexpr size_t OFF_WP = OFF_WCAT + 2 * SZ_WCAT;
constexpr size_t OFF_WO = OFF_WP + 2 * SZ_WP;
constexpr size_t OFF_WF1 = OFF_WO + 2 * SZ_WO;
constexpr size_t OFF_WF2 = OFF_WF1 + 2 * SZ_WF;
constexpr size_t OFF_CDK = OFF_WF2 + 2 * SZ_WF;
constexpr size_t OFF_CDV = OFF_CDK + 2097152;
constexpr size_t OFF_CWK = OFF_CDV + 2097152;
constexpr size_t OFF_CWV = OFF_CWK + 524288;
constexpr size_t OFF_MOD = OFF_CWV + 524288;
constexpr size_t OFF_ROPE = OFF_MOD + 245760;
constexpr size_t OFF_H = OFF_ROPE + 8192;
constexpr size_t OFF_OA = OFF_H + 16777216;
constexpr size_t OFF_OB = OFF_OA + 8388608;
constexpr size_t OFF_OC = OFF_OB + 8388608;
constexpr size_t OFF_MRG = OFF_OC + 8388608;
constexpr size_t OFF_R = OFF_MRG + 16777216;
constexpr size_t OFF_Z = OFF_R;
constexpr size_t OFF_G = OFF_Z + 8192ull * 3840 * 2;
constexpr size_t OFF_HID = OFF_R;
constexpr size_t OFF_Y = OFF_R + 8192ull * 4096 * 2;
constexpr size_t OFF_CNT = OFF_G + 8192ull * 3072 * 2;
constexpr size_t OFF_BAR = OFF_CNT + 16384;
constexpr size_t OFF_YB = OFF_BAR + 3456 * 4 + 256;
constexpr size_t WS_NEED = OFF_YB + 8192ull * 512 * 4;
constexpr int NTHR = 512;
constexpr int LDS_BYTES = 131072 + 64;
constexpr int LDS_ST = 131072 + 16;
constexpr int LDS_FLAG = 131072;

constexpr size_t OUT_X = 0, OUT_DK = 8388608, OUT_DV = 12582912, OUT_WK = 16777216, OUT_WV = 17825792, OUT_ST = 18874368;

struct Params {
  const float *x_prompt, *x_sample, *c, *cache_diff_k, *cache_diff_v, *cache_win_k, *cache_win_v, *state_ret, *c_ctx;
  const float *w_mod, *b_mod, *w_in, *diff_lam, *diff_norm_g, *win_sink, *ret_decay, *ret_norm_g;
  const float *w_pa, *w_pb, *w_pc, *w_gate, *b_gate, *w_o, *ln1_g, *ln1_b, *w_ff1, *w_ff2, *ln2_g, *ln2_b;
  float* out;
  char* ws;
  float lam_init[2];
};

__device__ __forceinline__ unsigned cvtpk(float lo, float hi) { f32x2_t v = {lo, hi}; bf16x2_t b = __builtin_convertvector(v, bf16x2_t); return __builtin_bit_cast(unsigned, b); }
__device__ __forceinline__ bf16_t f2bf(float f) { return (bf16_t)(cvtpk(f, 0.f) & 0xffffu); }
__device__ __forceinline__ float bf2f(unsigned short b) { return __uint_as_float(((unsigned)b) << 16); }
__device__ __forceinline__ float bflo(unsigned u) { return __uint_as_float(u << 16); }
__device__ __forceinline__ float bfhi(unsigned u) { return __uint_as_float(u & 0xffff0000u); }
__device__ __forceinline__ u32x2 pack4(f32x4 v) { u32x2 r; r.x = cvtpk(v[0], v[1]); r.y = cvtpk(v[2], v[3]); return r; }
__device__ __forceinline__ f32x4 unpack4(u32x2 u) { f32x4 r; r[0] = bflo(u.x); r[1] = bfhi(u.x); r[2] = bflo(u.y); r[3] = bfhi(u.y); return r; }
__device__ __forceinline__ s16x4 vtr(const char* p) { return __builtin_amdgcn_ds_read_tr16_b64_v4i16((lds_s16x4_ptr)(p)); }
__device__ __forceinline__ bf16x8 cat8(s16x4 lo, s16x4 hi) { return (bf16x8){lo[0], lo[1], lo[2], lo[3], hi[0], hi[1], hi[2], hi[3]}; }
__device__ __forceinline__ f32x4 mfma16(bf16x8 a, bf16x8 b, f32x4 c) { return __builtin_amdgcn_mfma_f32_16x16x32_bf16(a, b, c, 0, 0, 0); }
__device__ __forceinline__ float quad_sum(float v) { v += __shfl_xor(v, 16); v += __shfl_xor(v, 32); return v; }
__device__ __forceinline__ float quad_max(float v) { v = fmaxf(v, __shfl_xor(v, 16)); v = fmaxf(v, __shfl_xor(v, 32)); return v; }
__device__ __forceinline__ float wave_sum(float v) {
#pragma unroll
  for (int o = 32; o > 0; o >>= 1) v += __shfl_xor(v, o);
  return v;
}
__device__ __forceinline__ int lane_id() { return (int)__builtin_amdgcn_mbcnt_hi(~0u, __builtin_amdgcn_mbcnt_lo(~0u, 0u)); }
__device__ __forceinline__ int ozero() { int z; asm volatile("s_mov_b32 %0, 0" : "=s"(z)); return z; }
__device__ __forceinline__ int otid_w(int wbase) { asm volatile("" : "+s"(wbase)); return wbase | lane_id(); }
#define otid() otid_w(wb)
__device__ __forceinline__ char* opq(char* w) { return (char*)((uintptr_t)w ^ (uintptr_t)(unsigned)ozero()); }
__device__ __forceinline__ float* opqf(float* w) { return (float*)((uintptr_t)w ^ (uintptr_t)(unsigned)ozero()); }
__device__ __forceinline__ int row_group(int row) { return row < 4096 ? 0 : 1 + ((row - 4096) >> 10); }

#define WS(p) opq((p).ws)
#define OUTP(p) opqf((p).out)

namespace pg8 {
#define PG8_LAS __attribute__((address_space(3)))
constexpr int BM = 256, BK = 64, HALF = 128, HTB = HALF * BK * 2  , STAGE_BYTES = 8 * HTB, NXCD = 8, WGM = 8;

__host__ __device__ __forceinline__ int lds_byte(int r, int c) { const int st = (r >> 4) * 2 + (c >> 5), rr = r & 15, cc = c & 31, ob = rr * 64 + cc * 2; return st * 1024 + (ob ^ (((ob >> 9) & 1) << 5)); }
__host__ __device__ __forceinline__ void stage_rc(int b, int& R, int& C) { const int st = b / 1024, sb = b % 1024, swz = sb ^ (((sb >> 9) & 1) << 5); R = (st >> 1) * 16 + swz / 64; C = (st & 1) * 32 + (swz % 64) / 2; }
__host__ __device__ __forceinline__ int perm32(int rho) { const int n = rho >> 4, i = rho & 15; return 8 * (i >> 2) + 4 * n + (i & 3); }

struct Unit { int pm, pn, ko, sn, slot; };
struct Gemm { const bf16_t* A; const bf16_t* Bt; int ld, K; };

struct StaticOrder {
    int nM, nN, nwg, G, c, kt;
    __host__ __device__ __forceinline__ void init(int M, int N, int G_, int c_, int kt_) { nM = M / BM; nN = N / BM; nwg = nM * nN; G = G_; c = c_; kt = kt_; }
    __host__ __device__ __forceinline__ bool next(int i, Unit& u) const { return at((long)i * G + c, u); }
    __host__ __device__ __forceinline__ bool at(long L, Unit& u) const {
        if (L >= nwg) return false;
        int wgid = (int)L; { const int q = nwg / NXCD, r = nwg % NXCD, xcd = wgid % NXCD, off = wgid / NXCD; wgid = (xcd < r ? xcd * (q + 1) : r * (q + 1) + (xcd - r) * q) + off; }
        const int nig = WGM * nN, gid = wgid / nig, fm = gid * WGM, gsz = (nM - fm) < WGM ? (nM - fm) : WGM;
        u.pm = fm + ((wgid % nig) % gsz); u.pn = (wgid % nig) / gsz; u.ko = 0; u.sn = 1; u.slot = 0; return true;
    }
    __device__ __forceinline__ void a_ready(const Unit&) const {}
    __device__ __forceinline__ void done(const Unit&) const {}
};


template <class Epi, class Sched, bool ALIGN_EPI = false, bool SP2 = false>
__device__ __forceinline__ void gemm_phase(PG8_LAS unsigned char* lds, const Gemm g, const Sched& S, const Epi& E, int wbase) {
    const int tid = otid_w(wbase), wid = __builtin_amdgcn_readfirstlane(tid >> 6), lane = tid & 63, wr = wid >> 2, wc = wid & 3, fr = lane & 15, fq = lane >> 4;
    const int K = g.ld, nt = g.K / BK;
    unsigned voffA[2], voffB[2];
#pragma unroll
    for (int i = 0; i < 2; ++i) { int R, C; stage_rc(tid * 16 + i * 8192, R, C); const int Rb = Epi::PERM ? ((R & ~31) + perm32(R & 31)) : R;
        voffA[i] = (unsigned)(R * K + C) * 2u; voffB[i] = (unsigned)(Rb * K + C) * 2u; }
    const size_t kstep = (size_t)(BK * 2);
    const size_t hstep = (size_t)HALF * K * 2;
    const size_t tstep = 2 * hstep;
    const unsigned ldsw = (unsigned)wid * 1024u;
    const int aoff = lds_byte(wr * 64 + fr, fq * 8), boff = lds_byte(wc * 32 + fr, fq * 8);
#define PG8_SA(b, h) (((b) * 2 + (h)) * HTB)
#define PG8_SB(b, h) ((4 + (b) * 2 + (h)) * HTB)
#define PG8_STAGE(bufoff, gbase, voff) do { _Pragma("unroll") for (int _i = 0; _i < 2; ++_i) \
        __builtin_amdgcn_global_load_lds((const unsigned*)((const char*)(gbase) + (voff)[_i]), (PG8_LAS unsigned*)(lds + (bufoff) + ldsw + _i * 8192), 16, 0, 0); } while (0)
#define PG8_LDA(dst, b, h) do { _Pragma("unroll") for (int m = 0; m < 4; ++m) _Pragma("unroll") for (int k = 0; k < 2; ++k) dst[m][k] = *(const PG8_LAS bf16x8*)(lds + PG8_SA(b, h) + aoff + m * 2048 + k * 1024); } while (0)
#define PG8_LDB(dst, b, h) do { _Pragma("unroll") for (int n = 0; n < 2; ++n) _Pragma("unroll") for (int k = 0; k < 2; ++k) dst[n][k] = *(const PG8_LAS bf16x8*)(lds + PG8_SB(b, h) + boff + n * 2048 + k * 1024); } while (0)
#define PG8_MMA(ai, bj, At, Bt) do { __builtin_amdgcn_s_setprio(1); _Pragma("unroll") for (int m = 0; m < 4; ++m) _Pragma("unroll") for (int n = 0; n < 2; ++n) _Pragma("unroll") for (int k = 0; k < 2; ++k) \
        acc[ai][bj][m][n] = __builtin_amdgcn_mfma_f32_16x16x32_bf16(Bt[n][k], At[m][k], acc[ai][bj][m][n], 0, 0, 0); __builtin_amdgcn_s_setprio(0); } while (0)
#define PG8_WAIT_V(n) asm volatile("s_waitcnt vmcnt(" #n ")" ::: "memory")
#define PG8_WAIT_L(n) asm volatile("s_waitcnt lgkmcnt(" #n ")" ::: "memory")
#define PG8_BAR __builtin_amdgcn_s_barrier()
#define PG8_SCHED __builtin_amdgcn_sched_barrier(0)
    Unit cur, nxt; int ui = 0;
    if (!S.next(0, cur)) return;
    f32x4 acc[2][2][4][2];
#pragma unroll
    for (int a = 0; a < 2; ++a)
#pragma unroll
        for (int b = 0; b < 2; ++b)
#pragma unroll
            for (int m = 0; m < 4; ++m)
#pragma unroll
                for (int n = 0; n < 2; ++n) acc[a][b][m][n] = (f32x4){0.f, 0.f, 0.f, 0.f};
    bf16x8 At[4][2], B0[2][2], B1[2][2];
    const char* cA = (const char*)g.A + (size_t)cur.pm * tstep + (size_t)cur.ko * 2; const char* cB = (const char*)g.Bt + (size_t)cur.pn * tstep + (size_t)cur.ko * 2;
    S.a_ready(cur);
    if constexpr (SP2) {
        PG8_STAGE(PG8_SB(0, 0), cB, voffB); PG8_STAGE(PG8_SB(0, 1), cB + hstep, voffB); PG8_STAGE(PG8_SA(0, 0), cA, voffA); PG8_STAGE(PG8_SA(0, 1), cA + hstep, voffA);
        if (wr == 1) PG8_BAR;
        PG8_WAIT_V(2); PG8_BAR;
        PG8_STAGE(PG8_SB(1, 0), cB + kstep, voffB); PG8_STAGE(PG8_SA(1, 0), cA + kstep, voffA); PG8_STAGE(PG8_SB(1, 1), cB + hstep + kstep, voffB);
        PG8_WAIT_V(6); PG8_BAR;
    } else {
        PG8_STAGE(PG8_SB(0, 0), cB, voffB); PG8_STAGE(PG8_SA(0, 0), cA, voffA); PG8_STAGE(PG8_SB(0, 1), cB + hstep, voffB); PG8_STAGE(PG8_SA(0, 1), cA + hstep, voffA);
        if (wr == 1) PG8_BAR;
        PG8_WAIT_V(4); PG8_BAR;
        PG8_STAGE(PG8_SB(1, 0), cB + kstep, voffB); PG8_STAGE(PG8_SA(1, 0), cA + kstep, voffA); PG8_STAGE(PG8_SB(1, 1), cB + hstep + kstep, voffB);
        PG8_WAIT_V(6); PG8_BAR;
    }
    for (;;) {
        const bool has_next = S.next(ui + 1, nxt);
        const char* nA = has_next ? (const char*)g.A + (size_t)nxt.pm * tstep + (size_t)nxt.ko * 2 : cA; const char* nB = has_next ? (const char*)g.Bt + (size_t)nxt.pn * tstep + (size_t)nxt.ko * 2 : cB;
        const int nt_u = cur.sn == 2 ? (nt >> 1) : nt;
        for (int t = 0; t < nt_u; t += 2) {
            const bool last = (t == nt_u - 2);
            const char* a1 = cA + (size_t)(t + 1) * kstep;
            const char* a2 = last ? nA : cA + (size_t)(t + 2) * kstep; const char* b2 = last ? nB : cB + (size_t)(t + 2) * kstep;
            const char* a3 = a2 + kstep; const char* b3 = b2 + kstep;
            if (last && has_next) S.a_ready(nxt);
            if constexpr (SP2) {
            PG8_LDB(B0, 0, 0); PG8_LDB(B1, 0, 1); PG8_SCHED; PG8_LDA(At, 0, 0); PG8_STAGE(PG8_SA(1, 1), a1 + hstep, voffA);
            PG8_WAIT_V(8); PG8_WAIT_L(0); PG8_BAR; PG8_MMA(0, 0, At, B0); PG8_MMA(0, 1, At, B1); PG8_BAR; PG8_SCHED;
            PG8_LDA(At, 0, 1); PG8_STAGE(PG8_SB(0, 0), b2, voffB); PG8_STAGE(PG8_SB(0, 1), b2 + hstep, voffB); PG8_STAGE(PG8_SA(0, 0), a2, voffA);
            PG8_WAIT_V(8); PG8_WAIT_L(0); PG8_BAR; PG8_MMA(1, 0, At, B0); PG8_MMA(1, 1, At, B1); PG8_BAR; PG8_SCHED;
            PG8_LDB(B0, 1, 0); PG8_LDB(B1, 1, 1); PG8_SCHED; PG8_LDA(At, 1, 0); PG8_STAGE(PG8_SA(0, 1), a2 + hstep, voffA);
            PG8_WAIT_V(8); PG8_WAIT_L(0); PG8_BAR; PG8_MMA(0, 0, At, B0); PG8_MMA(0, 1, At, B1); PG8_BAR; PG8_SCHED;
            PG8_LDA(At, 1, 1); PG8_STAGE(PG8_SB(1, 0), b3, voffB); PG8_STAGE(PG8_SB(1, 1), b3 + hstep, voffB); PG8_STAGE(PG8_SA(1, 0), a3, voffA);
            PG8_WAIT_V(8); PG8_WAIT_L(0); PG8_BAR; PG8_MMA(1, 0, At, B0); PG8_MMA(1, 1, At, B1); PG8_BAR; PG8_SCHED;
            } else {
            PG8_LDB(B0, 0, 0); PG8_SCHED; PG8_LDA(At, 0, 0); PG8_STAGE(PG8_SA(1, 1), a1 + hstep, voffA);
            PG8_WAIT_L(8); PG8_BAR; PG8_WAIT_L(0); PG8_MMA(0, 0, At, B0); PG8_BAR; PG8_SCHED;
            PG8_LDB(B1, 0, 1); PG8_STAGE(PG8_SB(0, 0), b2, voffB);
            PG8_BAR; PG8_WAIT_L(0); PG8_MMA(0, 1, At, B1); PG8_BAR;
            PG8_LDA(At, 0, 1); PG8_STAGE(PG8_SA(0, 0), a2, voffA);
            PG8_BAR; PG8_WAIT_L(0); PG8_MMA(1, 0, At, B0); PG8_BAR; PG8_SCHED;
            PG8_STAGE(PG8_SB(0, 1), b2 + hstep, voffB);
            PG8_WAIT_V(6); PG8_BAR; PG8_MMA(1, 1, At, B1); PG8_BAR;
            PG8_LDB(B0, 1, 0); PG8_SCHED; PG8_LDA(At, 1, 0); PG8_STAGE(PG8_SA(0, 1), a2 + hstep, voffA);
            PG8_WAIT_L(8); PG8_BAR; PG8_WAIT_L(0); PG8_MMA(0, 0, At, B0); PG8_BAR; PG8_SCHED;
            PG8_LDB(B1, 1, 1); PG8_STAGE(PG8_SB(1, 0), b3, voffB);
            PG8_BAR; PG8_WAIT_L(0); PG8_MMA(0, 1, At, B1); PG8_BAR;
            PG8_LDA(At, 1, 1); PG8_STAGE(PG8_SA(1, 0), a3, voffA);
            PG8_BAR; PG8_WAIT_L(0); PG8_MMA(1, 0, At, B0); PG8_BAR; PG8_SCHED;
            PG8_STAGE(PG8_SB(1, 1), b3 + hstep, voffB);
            PG8_WAIT_V(6); PG8_BAR; PG8_MMA(1, 1, At, B1); PG8_BAR;
            }
        }
        if constexpr (ALIGN_EPI) { if (wr == 0) PG8_BAR; }
        if constexpr (!Epi::AFTER_DRAIN) { E(acc, cur, wr, wc, fr, fq); S.done(cur); }
        if (!has_next) break;
#pragma unroll
        for (int a = 0; a < 2; ++a)
#pragma unroll
            for (int b = 0; b < 2; ++b)
#pragma unroll
                for (int m = 0; m < 4; ++m)
#pragma unroll
                    for (int n = 0; n < 2; ++n) acc[a][b][m][n] = (f32x4){0.f, 0.f, 0.f, 0.f};
        cur = nxt; cA = nA; cB = nB; ++ui;
        if constexpr (ALIGN_EPI) { if (wr == 1) PG8_BAR; }
    }
    PG8_WAIT_V(0);
    if constexpr (!ALIGN_EPI) { if (wr == 0) PG8_BAR; }
    PG8_BAR;
    if constexpr (Epi::AFTER_DRAIN) { E.fused(acc, cur, wr, wc, fr, fq, lds, wid, lane); S.done(cur); }
#undef PG8_SA
#undef PG8_SB
#undef PG8_STAGE
#undef PG8_LDA
#undef PG8_LDB
#undef PG8_MMA
#undef PG8_WAIT_V
#undef PG8_WAIT_L
#undef PG8_BAR
#undef PG8_SCHED
}
}

typedef f32x4 AccT[2][2][4][2];
struct SchedG1 {
  pg8::StaticOrder sz, sg;
  __device__ __forceinline__ bool at(int L, pg8::Unit& u) const {
    if (L < 480) return sz.at(L, u);
    if (!sg.at(L - 480, u)) return false;
    u.pn += 15; return true;
  }
  __device__ __forceinline__ bool next(int i, pg8::Unit& u) const { return i < 3 && at(i * 256 + sz.c, u); }
  __device__ __forceinline__ void a_ready(const pg8::Unit&) const {}
  __device__ __forceinline__ void done(const pg8::Unit&) const {}
};
struct SchedOne {
  pg8::Unit u0;
  __device__ __forceinline__ bool next(int i, pg8::Unit& u) const { if (i > 0) return false; u = u0; return true; }
  __device__ __forceinline__ void a_ready(const pg8::Unit&) const {}
  __device__ __forceinline__ void done(const pg8::Unit&) const {}
};
struct SchedBr {
  pg8::StaticOrder so;
  __device__ __forceinline__ bool next(int i, pg8::Unit& u) const {
    if (i > 1 || (i == 1 && so.c >= 128)) return false;
    const int t = so.c & 127, br = i == 0 ? (so.c >> 7) : 2;
    so.at(t, u); u.pm += br * 32; u.pn += br * 4; u.sn = 3; u.slot = t; return true;
  }
  __device__ __forceinline__ void a_ready(const pg8::Unit&) const {}
  __device__ __forceinline__ void done(const pg8::Unit&) const {}
};
struct SchedSplit2 {
  pg8::StaticOrder so; int khalf_len, sn;
  __device__ __forceinline__ bool next(int i, pg8::Unit& u) const {
    if (i >= 1) return false;
    const int t = so.c & 127;
    so.at(t, u); u.ko = (so.c >> 7) * khalf_len; u.sn = sn; u.slot = t; return true;
  }
  __device__ __forceinline__ void a_ready(const pg8::Unit&) const {}
  __device__ __forceinline__ void done(const pg8::Unit&) const {}
};
struct PartRef { __amdgpu_buffer_rsrc_t rs; int voff; };
template <bool BF16P> __device__ __forceinline__ f32x4 part_ld(const PartRef& pr, int soff) {
  if (BF16P) return unpack4(__builtin_bit_cast(u32x2, __builtin_amdgcn_raw_buffer_load_b64(pr.rs, pr.voff, soff, 0)));
  return __builtin_bit_cast(f32x4, __builtin_amdgcn_raw_buffer_load_b128(pr.rs, pr.voff, soff, 0));
}
template <int NP, bool BF16P> __device__ __forceinline__ f32x4 accv(const AccT& acc, int ai, int bj, int m, int n, const PartRef& pr) {
  constexpr int PB = BF16P ? 8 : 16, IMG = 16384 * PB;
  const int q = ai * 16 + bj * 8 + m * 2 + n;
  f32x4 v = acc[ai][bj][m][n];
  if (NP >= 1) v += part_ld<BF16P>(pr, q * 512 * PB);
  if (NP >= 2) v += part_ld<BF16P>(pr, IMG + q * 512 * PB);
  return v;
}
template <class Inner, bool BF16P, int NPC>
struct EpiSplit {
  static constexpr bool PERM = Inner::PERM, AFTER_DRAIN = false;
  Inner in; char* ws; size_t part_off; int cnt_base; LAS unsigned char* ldsp; int wbase;
  __device__ __forceinline__ void operator()(AccT& acc, const pg8::Unit& u, int, int, int, int) const {
    int lane_ = lane_id(), wv_ = wbase; asm volatile("" : "+v"(lane_), "+s"(wv_));
    const int fr = lane_ & 15, fq = lane_ >> 4, wr = wv_ >> 8, wc = (wv_ >> 6) & 3;
    in.pre(acc, u, wr, wc, fr, fq);
    constexpr int PB = BF16P ? 8 : 16, IMG = 16384 * PB;
    if (u.sn == 1) { const PartRef pr0{__builtin_amdgcn_make_buffer_rsrc((void*)ws, (short)0, 0, 0x00020000), 0}; in.template fin<0, BF16P>(acc, u, wr, wc, fr, fq, pr0); return; }
    const int tid = wv_ + lane_;
    char* w_ = opq(ws);
    unsigned* c = (unsigned*)(w_ + OFF_CNT) + cnt_base + u.slot * 2;
    LAS int* role = (LAS int*)(ldsp + LDS_FLAG);
    if (tid == 0) { *role = (int)__hip_atomic_fetch_add(c, 1u, __ATOMIC_RELAXED, __HIP_MEMORY_SCOPE_AGENT); asm volatile("s_waitcnt lgkmcnt(0)" ::: "memory"); }
    __builtin_amdgcn_s_barrier(); asm volatile("" ::: "memory");
    const int r = __builtin_amdgcn_readfirstlane(*role);
    if (r < NPC) {
      const __amdgpu_buffer_rsrc_t rs = __builtin_amdgcn_make_buffer_rsrc((void*)(w_ + part_off + (size_t)(u.slot * NPC + r) * IMG), (short)0, IMG, 0x00020000);
#pragma unroll
      for (int q = 0; q < 32; ++q) {
        if (BF16P) { typedef unsigned v2u_ __attribute__((__vector_size__(2 * sizeof(unsigned)))); const u32x2 t_ = pack4(acc[q >> 4][(q >> 3) & 1][(q >> 1) & 3][q & 1]); __builtin_amdgcn_raw_buffer_store_b64(__builtin_bit_cast(v2u_, t_), rs, tid * PB, q * 512 * PB, 0); }
        else __builtin_amdgcn_raw_buffer_store_b128(__builtin_bit_cast(u32x4, acc[q >> 4][(q >> 3) & 1][(q >> 1) & 3][q & 1]), rs, tid * PB, q * 512 * PB, 0);
      }
      asm volatile("s_waitcnt vmcnt(0)" ::: "memory");
      __builtin_amdgcn_s_barrier(); asm volatile("" ::: "memory");
      if (tid == 0) {
        __builtin_amdgcn_fence(__ATOMIC_RELEASE, "agent");
        asm volatile("s_waitcnt vmcnt(0)" ::: "memory");
        (void)__hip_atomic_fetch_add(c + 1, 1u, __ATOMIC_RELAXED, __HIP_MEMORY_SCOPE_AGENT);
      }
      return;
    }
    if (tid == 0) {
      unsigned sp = 0;
      while (__hip_atomic_load(c + 1, __ATOMIC_RELAXED, __HIP_MEMORY_SCOPE_AGENT) < (unsigned)NPC) { __builtin_amdgcn_s_sleep(1); if (++sp > (1u << 22)) break; }
      __builtin_amdgcn_fence(__ATOMIC_ACQUIRE, "agent");
      asm volatile("s_waitcnt vmcnt(0)" ::: "memory");
    }
    __builtin_amdgcn_s_barrier(); asm volatile("" ::: "memory");
    const PartRef prc{__builtin_amdgcn_make_buffer_rsrc((void*)(w_ + part_off + (size_t)(u.slot * NPC) * IMG), (short)0, NPC * IMG, 0x00020000), tid * PB};
    in.template fin<NPC, BF16P>(acc, u, wr, wc, fr, fq, prc);
  }
};
struct EpiG1 {
  static constexpr bool PERM = true, AFTER_DRAIN = false;
  __device__ __forceinline__ void pre(AccT&, const pg8::Unit&, int, int, int, int) const {}
  char* ws; const float* b_gate; float* out_; int l;
  template <int NP, bool BF16P> __device__ __forceinline__ void fin(const AccT& acc, const pg8::Unit& u, int wr, int wc, int fr, int fq, const PartRef& pb) const {
    char* w_ = opq(ws); float* out = opqf(out_);
    bf16_t* Z = (bf16_t*)(w_ + OFF_Z); bf16_t* G = (bf16_t*)(w_ + OFF_G); const float* cosT = (const float*)(w_ + OFF_ROPE); const float* sinT = cosT + 1024;
    const bool lat = u.pm >= 16;
    const bool lo = fq < 2;
    const int fi = (fq & 1) * 8;
#pragma unroll
    for (int bj = 0; bj < 2; ++bj) {
      const int colg = u.pn * 256 + bj * 128 + wc * 32;
      if (colg < 3840) {
        const bool rope = lat && (colg < 1024 || (colg >= 1536 && colg < 2176));
        const bool second = (colg & 32) != 0;
        const float scl = (colg < 512 || (colg >= 1536 && colg < 2048) || (colg >= 2560 && colg < 2816)) ? 0.125f : 1.f;
        float* outp = nullptr; int outld = 0, outc = 0;
        if (!lat) {
          if (colg >= 512 && colg < 1024) { outp = out + OUT_DK; outld = 512; outc = colg - 512; }
          else if (colg >= 1024 && colg < 1536) { outp = out + OUT_DV; outld = 512; outc = colg - 1024; }
          else if (colg >= 2048 && colg < 2176) { outp = out + OUT_WK; outld = 128; outc = colg - 2048; }
          else if (colg >= 2176 && colg < 2304) { outp = out + OUT_WV; outld = 128; outc = colg - 2176; }
        }
#pragma unroll
        for (int ai = 0; ai < 2; ++ai)
#pragma unroll
          for (int m = 0; m < 4; ++m) {
            const int row = u.pm * 256 + ai * 128 + wr * 64 + m * 16 + fr;
            f32x4 v0 = accv<NP, BF16P>(acc, ai, bj, m, 0, pb), v1 = accv<NP, BF16P>(acc, ai, bj, m, 1, pb);
            if (rope) {
              const int t = (row - 4096) & 1023, pos = second ? (t & 63) : (t >> 6);
              const f32x4 ca = *(const f32x4*)(cosT + pos * 16 + fi), cb = *(const f32x4*)(cosT + pos * 16 + fi + 4);
              const f32x4 sa = *(const f32x4*)(sinT + pos * 16 + fi), sb = *(const f32x4*)(sinT + pos * 16 + fi + 4);
#pragma unroll
              for (int j = 0; j < 4; ++j) {
                const float p0 = __shfl_xor(v0[j], 32), p1 = __shfl_xor(v1[j], 32);
                v0[j] = lo ? v0[j] * ca[j] - p0 * sa[j] : p0 * sa[j] + v0[j] * ca[j];
                v1[j] = lo ? v1[j] * cb[j] - p1 * sb[j] : p1 * sb[j] + v1[j] * cb[j];
              }
            }
            if (outp) {
              float* op = outp + (size_t)(((row >> 8) * 2 + l) * 256 + (row & 255)) * outld + outc + fq * 8;
              *(f32x4*)op = v0; *(f32x4*)(op + 4) = v1;
            }
            const u32x2 a0 = pack4(v0 * scl), a1 = pack4(v1 * scl);
            *(u32x4*)(Z + (size_t)row * 3840 + colg + fq * 8) = (u32x4){a0.x, a0.y, a1.x, a1.y};
          }
      } else {
        const int gc = colg - 3840;
        const f32x4 b0 = *(const f32x4*)(b_gate + l * 3072 + gc + fq * 8), b1 = *(const f32x4*)(b_gate + l * 3072 + gc + fq * 8 + 4);
#pragma unroll
        for (int ai = 0; ai < 2; ++ai)
#pragma unroll
          for (int m = 0; m < 4; ++m) {
            const int row = u.pm * 256 + ai * 128 + wr * 64 + m * 16 + fr;
            f32x4 v0 = accv<NP, BF16P>(acc, ai, bj, m, 0, pb) + b0, v1 = accv<NP, BF16P>(acc, ai, bj, m, 1, pb) + b1;
#pragma unroll
            for (int j = 0; j < 4; ++j) { v0[j] = __builtin_amdgcn_rcpf(1.f + __expf(-v0[j])); v1[j] = __builtin_amdgcn_rcpf(1.f + __expf(-v1[j])); }
            const u32x2 a0 = pack4(v0), a1 = pack4(v1);
            *(u32x4*)(G + (size_t)row * 3072 + gc + fq * 8) = (u32x4){a0.x, a0.y, a1.x, a1.y};
          }
      }
    }
  }
};
struct EpiG2 {
  static constexpr bool PERM = true, AFTER_DRAIN = false;
  char* ws;
  __device__ __forceinline__ void pre(AccT& acc, const pg8::Unit& u, int wr, int wc, int fr, int fq) const {
    const bf16_t* G = (const bf16_t*)(opq(ws) + OFF_G);
    const int br = u.pm >> 5, pm = u.pm & 31, pn = u.pn & 3;
#pragma unroll
    for (int ai = 0; ai < 2; ++ai)
#pragma unroll
      for (int m = 0; m < 4; ++m) {
        const int row = pm * 256 + ai * 128 + wr * 64 + m * 16 + fr;
#pragma unroll
        for (int bj = 0; bj < 2; ++bj) {
          const int col = pn * 256 + bj * 128 + wc * 32 + fq * 8;
          const u32x4 g = *(const u32x4*)(G + (size_t)row * 3072 + br * 1024 + col);
          acc[ai][bj][m][0] *= unpack4((u32x2){g.x, g.y});
          acc[ai][bj][m][1] *= unpack4((u32x2){g.z, g.w});
        }
        asm volatile("" ::: "memory");
      }
  }
  template <int NP, bool BF16P> __device__ __forceinline__ void fin(const AccT& acc, const pg8::Unit& u, int wr, int wc, int fr, int fq, const PartRef& pb) const {
    bf16_t* MRG = (bf16_t*)(opq(ws) + OFF_MRG);
    const int pm = u.pm & 31, pn = u.pn & 3;
#pragma unroll
    for (int ai = 0; ai < 2; ++ai)
#pragma unroll
      for (int m = 0; m < 4; ++m) {
        const int row = pm * 256 + ai * 128 + wr * 64 + m * 16 + fr;
#pragma unroll
        for (int bj = 0; bj < 2; ++bj) {
          const int col = pn * 256 + bj * 128 + wc * 32 + fq * 8;
          const u32x2 a0 = pack4(accv<NP, BF16P>(acc, ai, bj, m, 0, pb)), a1 = pack4(accv<NP, BF16P>(acc, ai, bj, m, 1, pb));
          *(u32x4*)(MRG + (size_t)row * 1024 + col) = (u32x4){a0.x, a0.y, a1.x, a1.y};
        }
      }
  }
};
struct EpiG3 {
  static constexpr bool PERM = true, AFTER_DRAIN = false;
  char* ws; const float* xc_; const float* xl_; int l, goff;
  __device__ __forceinline__ void pre(AccT&, const pg8::Unit&, int, int, int, int) const {}
  template <int NP, bool BF16P> __device__ __forceinline__ void fin(const AccT& acc, const pg8::Unit& u, int wr, int wc, int fr, int fq, const PartRef& pb) const {
    char* w_ = opq(ws);
    const float* xc = opqf((float*)xc_); const float* xl = opqf((float*)xl_);
    const float* mod = (const float*)(w_ + OFF_MOD) + l * 5 * 6144 + goff; bf16_t* Y = (bf16_t*)(w_ + OFF_Y);
#pragma unroll
    for (int ai = 0; ai < 2; ++ai)
#pragma unroll
      for (int m = 0; m < 4; ++m) {
        const int row = u.pm * 256 + ai * 128 + wr * 64 + m * 16 + fr;
        const float* xp = row < 4096 ? xc + (size_t)row * 1024 : xl + (size_t)(row - 4096) * 1024;
        const float* gp = mod + row_group(row) * 6144;
#pragma unroll
        for (int bj = 0; bj < 2; ++bj) {
          const int col = u.pn * 256 + bj * 128 + wc * 32 + fq * 8;
          const u32x2 a0 = pack4(*(const f32x4*)(xp + col) * ALPHA_RES + *(const f32x4*)(gp + col) * accv<NP, BF16P>(acc, ai, bj, m, 0, pb));
          const u32x2 a1 = pack4(*(const f32x4*)(xp + col + 4) * ALPHA_RES + *(const f32x4*)(gp + col + 4) * accv<NP, BF16P>(acc, ai, bj, m, 1, pb));
          *(u32x4*)(Y + (size_t)row * 1024 + col) = (u32x4){a0.x, a0.y, a1.x, a1.y};
        }
      }
  }
};
struct EpiG5 {
  static constexpr bool PERM = true, AFTER_DRAIN = false;
  char* ws;
  __device__ __forceinline__ void pre(AccT&, const pg8::Unit&, int, int, int, int) const {}
  template <int NP, bool BF16P> __device__ __forceinline__ void fin(const AccT& acc, const pg8::Unit& u, int wr, int wc, int fr, int fq, const PartRef&) const {
    bf16_t* P = (bf16_t*)(opq(ws) + (u.ko ? OFF_OA : OFF_Y));
#pragma unroll
    for (int ai = 0; ai < 2; ++ai)
#pragma unroll
      for (int m = 0; m < 4; ++m) {
        const int row = u.pm * 256 + ai * 128 + wr * 64 + m * 16 + fr;
#pragma unroll
        for (int bj = 0; bj < 2; ++bj) {
          const int col = u.pn * 256 + bj * 128 + wc * 32 + fq * 8;
          const u32x2 a0 = pack4(acc[ai][bj][m][0]), a1 = pack4(acc[ai][bj][m][1]);
          *(u32x4*)(P + (size_t)row * 1024 + col) = (u32x4){a0.x, a0.y, a1.x, a1.y};
        }
      }
  }
};
struct EpiG4 {
  static constexpr bool PERM = true, AFTER_DRAIN = false;
  char* ws; int wbase;
  __device__ __forceinline__ void operator()(const AccT& acc, const pg8::Unit& u, int, int, int, int) const {
    int lane_ = lane_id(), wv_ = wbase; asm volatile("" : "+v"(lane_), "+s"(wv_));
    const int fr = lane_ & 15, fq = lane_ >> 4, wr = wv_ >> 8, wc = (wv_ >> 6) & 3;
    bf16_t* HID = (bf16_t*)(opq(ws) + OFF_HID);
#pragma unroll
    for (int ai = 0; ai < 2; ++ai)
#pragma unroll
      for (int m = 0; m < 4; ++m) {
        const int row = u.pm * 256 + ai * 128 + wr * 64 + m * 16 + fr;
#pragma unroll
        for (int bj = 0; bj < 2; ++bj) {
          const int col = u.pn * 256 + bj * 128 + wc * 32 + fq * 8;
          f32x4 v0 = acc[ai][bj][m][0], v1 = acc[ai][bj][m][1];
#pragma unroll
          for (int j = 0; j < 4; ++j) { const float r0 = fmaxf(v0[j], 0.f), r1 = fmaxf(v1[j], 0.f); v0[j] = r0 * r0; v1[j] = r1 * r1; }
          const u32x2 a0 = pack4(v0), a1 = pack4(v1);
          *(u32x4*)(HID + (size_t)row * 4096 + col) = (u32x4){a0.x, a0.y, a1.x, a1.y};
        }
      }
  }
};

__device__ void job_mod(const Params& p, int wb, int j, char* lds) {
  const int tid = otid();
  const int l = j / 96, chunk = j % 96;
  float* sil = (float*)lds;
  float* red = (float*)(lds + 20480);
  for (int i = tid; i < 5 * 1024; i += NTHR) {
    const int g = i >> 10, k = i & 1023;
    const float cv = (g == 0) ? p.c_ctx[k] : p.c[(g - 1) * 1024 + k];
    sil[i] = cv / (1.f + expf(-cv));
  }
  __syncthreads();
  const int cg4 = tid & 15, kg = tid >> 4;
  f32x4 acc[5];
#pragma unroll
  for (int g = 0; g < 5; ++g) acc[g] = (f32x4){0.f, 0.f, 0.f, 0.f};
  const float* w = p.w_mod + (size_t)l * 1024 * 6144 + chunk * 64 + cg4 * 4;
#pragma unroll 1
  for (int k0 = 0; k0 < 32; k0 += 8) {
    f32x4 wv[8];
#pragma unroll
    for (int e = 0; e < 8; ++e) wv[e] = *(const f32x4*)(w + (size_t)(kg * 32 + k0 + e) * 6144);
#pragma unroll
    for (int e = 0; e < 8; ++e)
#pragma unroll
      for (int g = 0; g < 5; ++g) acc[g] += wv[e] * sil[g * 1024 + kg * 32 + k0 + e];
  }
#pragma unroll
  for (int g = 0; g < 5; ++g) *(f32x4*)(red + (kg * 5 + g) * 64 + cg4 * 4) = acc[g];
  __syncthreads();
  float* MOD = (float*)(WS(p) + OFF_MOD);
  if (tid < 320) {
    const int g = tid >> 6, cc = tid & 63;
    float s = p.b_mod[l * 6144 + chunk * 64 + cc];
    for (int q = 0; q < 32; ++q) s += red[(q * 5 + g) * 64 + cc];
    MOD[(l * 5 + g) * 6144 + chunk * 64 + cc] = s;
  }
  __syncthreads();
}
__device__ void job_rope(const Params& p, int wb) {
  float* cosT = (float*)(WS(p) + OFF_ROPE);
  float* sinT = cosT + 1024;
  for (int t = otid(); t < 1024; t += NTHR) {
    const int pos = t >> 4, i = t & 15;
    const float inv = exp2f(-(float)i * (13.287712379549449f / 16.f));
    const float a = (float)pos * inv;
    cosT[t] = cosf(a); sinT[t] = sinf(a);
  }
}
__device__ void job_cache(const Params& p, int wb, int j) {
  const float* src; bf16_t* dst; int jj;
  if (j < 256) { src = p.cache_diff_k; dst = (bf16_t*)(WS(p) + OFF_CDK); jj = j; }
  else if (j < 512) { src = p.cache_diff_v; dst = (bf16_t*)(WS(p) + OFF_CDV); jj = j - 256; }
  else if (j < 576) { src = p.cache_win_k; dst = (bf16_t*)(WS(p) + OFF_CWK); jj = j - 512; }
  else { src = p.cache_win_v; dst = (bf16_t*)(WS(p) + OFF_CWV); jj = j - 576; }
  const size_t e = (size_t)jj * 4096 + otid() * 8;
  const f32x4 a = *(const f32x4*)(src + e), b = *(const f32x4*)(src + e + 4);
  u32x4 o; o.x = cvtpk(a[0], a[1]); o.y = cvtpk(a[2], a[3]); o.z = cvtpk(b[0], b[1]); o.w = cvtpk(b[2], b[3]);
  *(u32x4*)(dst + e) = o;
}
struct TileJob { const float* src; bf16_t* dst; int K, N, k0, n0; };
__device__ __forceinline__ TileJob tile_job(const Params& p, int l, int r) {
  TileJob t;
  if (r < 240) { t.src = p.w_in + (size_t)l * 1024 * 3840; t.K = 1024; t.N = 3840; t.dst = (bf16_t*)(WS(p) + OFF_WCAT + l * SZ_WCAT); }
  else if ((r -= 240) < 192) { t.src = p.w_gate + (size_t)l * 1024 * 3072; t.K = 1024; t.N = 3072; t.dst = (bf16_t*)(WS(p) + OFF_WCAT + l * SZ_WCAT) + (size_t)3840 * 1024; }
  else if ((r -= 192) < 32) { t.src = p.w_pa + (size_t)l * 512 * 1024; t.K = 512; t.N = 1024; t.dst = (bf16_t*)(WS(p) + OFF_WP + l * SZ_WP); }
  else if ((r -= 32) < 32) { t.src = p.w_pb + (size_t)l * 512 * 1024; t.K = 512; t.N = 1024; t.dst = (bf16_t*)(WS(p) + OFF_WP + l * SZ_WP) + (size_t)1024 * 512; }
  else if ((r -= 32) < 32) { t.src = p.w_pc + (size_t)l * 512 * 1024; t.K = 512; t.N = 1024; t.dst = (bf16_t*)(WS(p) + OFF_WP + l * SZ_WP) + (size_t)2 * 1024 * 512; }
  else if ((r -= 32) < 64) { t.src = p.w_o + (size_t)l * 1024 * 1024; t.K = 1024; t.N = 1024; t.dst = (bf16_t*)(WS(p) + OFF_WO + l * SZ_WO); }
  else if ((r -= 64) < 256) { t.src = p.w_ff1 + (size_t)l * 1024 * 4096; t.K = 1024; t.N = 4096; t.dst = (bf16_t*)(WS(p) + OFF_WF1 + l * SZ_WF); }
  else { r -= 256; t.src = p.w_ff2 + (size_t)l * 4096 * 1024; t.K = 4096; t.N = 1024; t.dst = (bf16_t*)(WS(p) + OFF_WF2 + l * SZ_WF); }
  const int ntn = t.N >> 7;
  t.k0 = (r / ntn) * 128; t.n0 = (r % ntn) * 128;
  return t;
}
__device__ __forceinline__ void tile_load(const TileJob& t, f32x4 (&v)[8], int tid) {
#pragma unroll
  for (int i = 0; i < 8; ++i) v[i] = *(const f32x4*)(t.src + (size_t)(t.k0 + (tid >> 5) + 16 * i) * t.N + t.n0 + (tid & 31) * 4);
}
__device__ __forceinline__ void tile_to_lds(const f32x4 (&v)[8], float* tile, int tid) {
#pragma unroll
  for (int i = 0; i < 8; ++i) {
    const int k = (tid >> 5) + 16 * i, n4 = (tid & 31) * 4;
    const int kb = k * 129 + (k >> 5) * 8;
    tile[kb + n4 + 0] = v[i][0]; tile[kb + n4 + 1] = v[i][1]; tile[kb + n4 + 2] = v[i][2]; tile[kb + n4 + 3] = v[i][3];
  }
}
__device__ __forceinline__ void tile_store(const TileJob& t, const float* tile, int tid) {
  const int n = tid >> 2, kc = (tid & 3) * 32, sk = (tid & 3) * 8;
  bf16_t* d = t.dst + (size_t)(t.n0 + n) * t.K + t.k0 + kc;
#pragma unroll
  for (int q = 0; q < 4; ++q) {
    u32x4 o;
    o.x = cvtpk(tile[(kc + q * 8 + 0) * 129 + sk + n], tile[(kc + q * 8 + 1) * 129 + sk + n]); o.y = cvtpk(tile[(kc + q * 8 + 2) * 129 + sk + n], tile[(kc + q * 8 + 3) * 129 + sk + n]);
    o.z = cvtpk(tile[(kc + q * 8 + 4) * 129 + sk + n], tile[(kc + q * 8 + 5) * 129 + sk + n]); o.w = cvtpk(tile[(kc + q * 8 + 6) * 129 + sk + n], tile[(kc + q * 8 + 7) * 129 + sk + n]);
    *(u32x4*)(d + q * 8) = o;
  }
}
__device__ void convert_tile(const Params& p, int wb, int l, int r, char* lds) {
  const int tid = otid();
  const TileJob t = tile_job(p, l, r);
  f32x4 v[8];
  tile_load(t, v, tid);
  tile_to_lds(v, (float*)lds, tid);
  __syncthreads();
  tile_store(t, (const float*)lds, tid);
  __syncthreads();
}
constexpr int NJ_MOD = 192, NJ_ROPE = 1, NJ_CACHE = 640, NJ_TR0 = 592;
constexpr int NJ_TOTAL = NJ_MOD + NJ_ROPE + NJ_CACHE + NJ_TR0;
__device__ void phase0(const Params& p, int wb, char* lds) {
  const int b = (int)blockIdx.x;
  if (b < NJ_MOD) job_mod(p, wb, b, lds);
  else if (b == NJ_MOD) job_rope(p, wb);
  constexpr int NREST = NJ_CACHE + NJ_TR0;
  for (int s = b; s < 320; s += (b < NJ_MOD ? 320 : 64))
    for (int r = s; r < NREST; r += 320) {
      if (r < NJ_CACHE) job_cache(p, wb, r);
      else convert_tile(p, wb, 0, r - NJ_CACHE, lds);
    }
}
constexpr int NJ_DEF = 512 + 1104, NJ_DEF_ITEMS = (NJ_DEF + 3) / 4;
__device__ __forceinline__ TileJob deferred_job(const Params& p, int j) { return j < 512 ? tile_job(p, 0, 592 + j) : tile_job(p, 1, j - 512); }
__device__ void deferred_convert(const Params& p, int wb, int j0, int j1, char* lds) {
  const int tid = otid();
  int j = j0;
  if (j >= j1) return;
  TileJob cur = deferred_job(p, j);
  f32x4 v[8];
  tile_load(cur, v, tid);
  for (;;) {
    tile_to_lds(v, (float*)lds, tid);
    __syncthreads();
    const int jn = j + 1;
    TileJob nxt = cur;
    if (jn < j1) { nxt = deferred_job(p, jn); tile_load(nxt, v, tid); }
    tile_store(cur, (const float*)lds, tid);
    __syncthreads();
    if (jn >= j1) break;
    cur = nxt; j = jn;
  }
}
__device__ void phase_h0(const Params& p, int wb) {
  const float* MOD = (const float*)(WS(p) + OFF_MOD);
  bf16_t* H = (bf16_t*)(WS(p) + OFF_H);
  for (int v = blockIdx.x * NTHR + otid(); v < 8192 * 128; v += gridDim.x * NTHR) {
    const int row = v >> 7, c8 = (v & 127) * 8;
    const float* x = (row < 4096 ? p.x_prompt + (size_t)row * 1024 : p.x_sample + (size_t)(row - 4096) * 1024) + c8;
    const float* md = MOD + row_group(row) * 6144;
    const f32x4 a = *(const f32x4*)x, b = *(const f32x4*)(x + 4);
    const f32x4 sh0 = *(const f32x4*)(md + c8), sh1 = *(const f32x4*)(md + c8 + 4);
    const f32x4 sc0 = *(const f32x4*)(md + 1024 + c8), sc1 = *(const f32x4*)(md + 1024 + c8 + 4);
    const f32x4 h0 = a * (sc0 + 1.f) + sh0, h1 = b * (sc1 + 1.f) + sh1;
    u32x4 o; o.x = cvtpk(h0[0], h0[1]); o.y = cvtpk(h0[2], h0[3]); o.z = cvtpk(h1[0], h1[1]); o.w = cvtpk(h1[2], h1[3]);
    *(u32x4*)(H + (size_t)row * 1024 + c8) = o;
  }
}

template <int KW> __device__ __forceinline__ int kaddr(int row, int ch) { return row * (KW * 2) + ((ch ^ (row & (KW / 8 - 1))) << 4); }
template <int DV> __device__ __forceinline__ int vaddr(int row, int boff) {
  if (DV == 128) return row * 256 + (boff ^ ((row & 7) << 5));
  return row * 128 + (boff ^ (((row >> 1) & 3) << 5));
}
template <int NMAPS, int DV>
__device__ __forceinline__ void attn_unit(int wbase, char* lds, const bf16_t* qp, int ldq,
                                          const bf16_t* K0, const bf16_t* V0, int ld0, int key0, int nt0,
                                          const bf16_t* K1, const bf16_t* V1, int ld1, int nt1,
                                          bool window, int qpos0, float m_init, float l_init,
                                          f32x4 (&o)[NMAPS][DV / 16], float (&lsum)[NMAPS]) {
  constexpr int KW = NMAPS * 64, NCHK = KW / 8, NKR = NCHK / 4, NVC = DV / 8, NVR = NVC / 4, KHB = 64 * KW * 2, VHB = 64 * DV * 2;
  const int tid = otid_w(wbase), lane = tid & 63, fr = lane & 15, fq = lane >> 4;
  bf16x8 qf[NMAPS][2];
#pragma unroll
  for (int mp = 0; mp < NMAPS; ++mp)
#pragma unroll
    for (int ks = 0; ks < 2; ++ks) qf[mp][ks] = *(const bf16x8*)(qp + (size_t)fr * ldq + mp * 64 + ks * 32 + fq * 8);
  float m[NMAPS], lr[NMAPS];
#pragma unroll
  for (int mp = 0; mp < NMAPS; ++mp) {
    m[mp] = m_init; lr[mp] = (fq == 0) ? l_init : 0.f;
#pragma unroll
    for (int c = 0; c < DV / 16; ++c) o[mp][c] = (f32x4){0.f, 0.f, 0.f, 0.f};
  }
  const int NT = nt0 + nt1;
  u32x4 kr[NKR], vr[NVR];
  auto load_tile = [&](int t) {
    const bf16_t* kp; const bf16_t* vp; int ld;
    if (t < nt0) { kp = K0 + (size_t)(key0 + t * 128) * ld0; vp = V0 + (size_t)(key0 + t * 128) * ld0; ld = ld0; }
    else { kp = K1 + (size_t)((t - nt0) * 128) * ld1; vp = V1 + (size_t)((t - nt0) * 128) * ld1; ld = ld1; }
#pragma unroll
    for (int i = 0; i < NKR; ++i) { const int idx = tid + NTHR * i, row = idx / NCHK, ch = idx % NCHK; kr[i] = *(const u32x4*)(kp + (size_t)row * ld + ch * 8); }
#pragma unroll
    for (int i = 0; i < NVR; ++i) { const int idx = tid + NTHR * i, row = idx / NVC, ch = idx % NVC; vr[i] = *(const u32x4*)(vp + (size_t)row * ld + ch * 8); }
  };
  load_tile(0);
  for (int t = 0; t < NT; ++t) {
    __syncthreads();
#pragma unroll
    for (int i = 0; i < NKR; ++i) { const int idx = tid + NTHR * i, row = idx / NCHK, ch = idx % NCHK; *(u32x4*)(lds + (row >> 6) * KHB + kaddr<KW>(row & 63, ch)) = kr[i]; }
#pragma unroll
    for (int i = 0; i < NVR; ++i) { const int idx = tid + NTHR * i, row = idx / NVC, ch = idx % NVC; *(u32x4*)(lds + 32768 + (row >> 6) * VHB + vaddr<DV>(row & 63, ch * 16)) = vr[i]; }
    __syncthreads();
    if (t + 1 < NT) load_tile(t + 1);
#pragma unroll
    for (int hf = 0; hf < 2; ++hf) {
      const char* kl = lds + hf * KHB;
      const char* vl = lds + 32768 + hf * VHB;
      bf16x8 pb[NMAPS][2];
#pragma unroll
      for (int mp = 0; mp < NMAPS; ++mp) {
        f32x4 s[4];
#pragma unroll
        for (int ksub = 0; ksub < 4; ++ksub) {
          s[ksub] = (f32x4){0.f, 0.f, 0.f, 0.f};
#pragma unroll
          for (int ks = 0; ks < 2; ++ks) {
            const bf16x8 kf = *(const bf16x8*)(kl + kaddr<KW>(ksub * 16 + fr, mp * 8 + ks * 4 + fq));
            s[ksub] = mfma16(kf, qf[mp][ks], s[ksub]);
          }
        }
        if (window && t < nt0) {
          const int qpos = qpos0 + fr, kb = key0 + t * 128 + hf * 64 + fq * 4;
#pragma unroll
          for (int ksub = 0; ksub < 4; ++ksub)
#pragma unroll
            for (int j = 0; j < 4; ++j) { const int d = kb + ksub * 16 + j - qpos; if (d > 128 || d < -128) s[ksub][j] = -1e30f; }
        }
        float mx = s[0][0];
#pragma unroll
        for (int ksub = 0; ksub < 4; ++ksub)
#pragma unroll
          for (int j = 0; j < 4; ++j) mx = fmaxf(mx, s[ksub][j]);
        mx = quad_max(mx);
        const float mnew = fmaxf(m[mp], mx * LOG2E);
        const float alpha = __builtin_amdgcn_exp2f(m[mp] - mnew);
        m[mp] = mnew;
        float ps = 0.f;
#pragma unroll
        for (int ksub = 0; ksub < 4; ++ksub)
#pragma unroll
          for (int j = 0; j < 4; ++j) { const float pv = __builtin_amdgcn_exp2f(s[ksub][j] * LOG2E - mnew); s[ksub][j] = pv; ps += pv; }
        lr[mp] = lr[mp] * alpha + ps;
        if (__any(alpha != 1.f)) {
#pragma unroll
          for (int c = 0; c < DV / 16; ++c) o[mp][c] *= alpha;
        }
#pragma unroll
        for (int kk = 0; kk < 2; ++kk) {
          u32x4 w; w.x = cvtpk(s[2 * kk][0], s[2 * kk][1]); w.y = cvtpk(s[2 * kk][2], s[2 * kk][3]);
          w.z = cvtpk(s[2 * kk + 1][0], s[2 * kk + 1][1]); w.w = cvtpk(s[2 * kk + 1][2], s[2 * kk + 1][3]);
          pb[mp][kk] = __builtin_bit_cast(bf16x8, w);
        }
      }
#pragma unroll
      for (int c = 0; c < DV / 16; ++c)
#pragma unroll
        for (int kk = 0; kk < 2; ++kk) {
          const int vrow = kk * 32 + fq * 4 + (fr >> 2), vb = (c * 16 + (lane & 3) * 4) * 2;
          const s16x4 lo = vtr(vl + vaddr<DV>(vrow, vb));
          const s16x4 hi = vtr(vl + vaddr<DV>(vrow + 16, vb));
          const bf16x8 vf = cat8(lo, hi);
#pragma unroll
          for (int mp = 0; mp < NMAPS; ++mp) o[mp][c] = mfma16(vf, pb[mp][kk], o[mp][c]);
        }
    }
  }
#pragma unroll
  for (int mp = 0; mp < NMAPS; ++mp) lsum[mp] = quad_sum(lr[mp]);
}

__device__ void unitA(const Params& p, int wb, int l, char* lds, int b_all, int h, int qb) {
  const bf16_t* Z = (const bf16_t*)(WS(p) + OFF_Z);
  const int tid = otid(), lane = tid & 63, wid = tid >> 6, fr = lane & 15, fq = lane >> 4;
  const bool lat = b_all >= 16; const int b = lat ? b_all - 16 : b_all;
  const int rowbase = lat ? 4096 + b * 1024 : b * 256;
  const int q0 = qb * 128 + wid * 16;
  const bf16_t* qp = Z + (size_t)(rowbase + q0) * 3840 + h * 128;
  const bf16_t* K0 = Z + (size_t)rowbase * 3840 + 512 + h * 128;
  const bf16_t* V0 = Z + (size_t)rowbase * 3840 + 1024 + h * 128;
  const bf16_t* K1 = (const bf16_t*)(WS(p) + OFF_CDK) + (size_t)((b * 2 + l) * 256) * 512 + h * 128;
  const bf16_t* V1 = (const bf16_t*)(WS(p) + OFF_CDV) + (size_t)((b * 2 + l) * 256) * 512 + h * 128;
  f32x4 o[2][8]; float ls[2];
  attn_unit<2, 128>(wb, lds, qp, 3840, K0, V0, 3840, 0, lat ? 8 : 2, K1, V1, 512, lat ? 2 : 0, false, 0, -1e30f, 0.f, o, ls);
  const float* lv = p.diff_lam + l * 256;
  const float d1 = wave_sum(lv[lane] * lv[64 + lane]), d2 = wave_sum(lv[128 + lane] * lv[192 + lane]);
  const float lam_init = p.lam_init[l];
  const float lam = expf(d1) - expf(d2) + lam_init;
  const float i0 = 1.f / ls[0], i1 = lam / ls[1];
  float ss = 0.f;
#pragma unroll
  for (int c = 0; c < 8; ++c) {
    o[0][c] = o[0][c] * i0 - o[1][c] * i1;
#pragma unroll
    for (int j = 0; j < 4; ++j) ss += o[0][c][j] * o[0][c][j];
  }
  ss = quad_sum(ss);
  const float r = rsqrtf(ss * (1.f / 128.f) + LN_EPS) * (1.f - lam_init);
  bf16_t* OA = (bf16_t*)(WS(p) + OFF_OA) + (size_t)(rowbase + q0 + fr) * 512 + h * 128 + fq * 4;
  const float* gn = p.diff_norm_g + l * 128 + fq * 4;
#pragma unroll
  for (int c = 0; c < 8; ++c) { const f32x4 g = *(const f32x4*)(gn + c * 16); *(u32x2*)(OA + c * 16) = pack4(o[0][c] * g * r); }
}
__device__ void unitB(const Params& p, int wb, int l, char* lds, int b_all, int kvh, int qb) {
  const bf16_t* Z = (const bf16_t*)(WS(p) + OFF_Z);
  const int tid = otid(), lane = tid & 63, wid = tid >> 6, fr = lane & 15, fq = lane >> 4;
  const bool lat = b_all >= 16; const int b = lat ? b_all - 16 : b_all;
  const int rowbase = lat ? 4096 + b * 1024 : b * 256;
  const int q0b = qb * 32, q0 = q0b + (wid >> 2) * 16, head = kvh * 4 + (wid & 3);
  const bf16_t* qp = Z + (size_t)(rowbase + q0) * 3840 + 1536 + head * 64;
  const bf16_t* K0 = Z + (size_t)rowbase * 3840 + 2048 + kvh * 64;
  const bf16_t* V0 = Z + (size_t)rowbase * 3840 + 2176 + kvh * 64;
  const bf16_t* K1 = (const bf16_t*)(WS(p) + OFF_CWK) + (size_t)((b * 2 + l) * 256) * 128 + kvh * 64;
  const bf16_t* V1 = (const bf16_t*)(WS(p) + OFF_CWV) + (size_t)((b * 2 + l) * 256) * 128 + kvh * 64;
  int key0 = 0, nt0 = 2, nt1 = 0;
  if (lat) {
    const int lo = q0b - 128 < 0 ? 0 : q0b - 128, hi = q0b + 159 > 1023 ? 1023 : q0b + 159;
    key0 = (lo >> 7) << 7; nt0 = (hi >> 7) - (lo >> 7) + 1; nt1 = 2;
  }
  const float sink = p.win_sink[l * 8 + head];
  f32x4 o[1][4]; float ls[1];
  attn_unit<1, 64>(wb, lds, qp, 3840, K0, V0, 3840, key0, nt0, K1, V1, 128, nt1, lat, q0, sink * LOG2E, 1.f, o, ls);
  const float inv = 1.f / ls[0];
  bf16_t* OB = (bf16_t*)(WS(p) + OFF_OB) + (size_t)(rowbase + q0 + fr) * 512 + head * 64 + fq * 4;
#pragma unroll
  for (int c = 0; c < 4; ++c) *(u32x2*)(OB + c * 16) = pack4(o[0][c] * inv);
}

__device__ void unitC(const Params& p, int wb, int l, char* lds, int b_all, int h, int dir) {
  const bf16_t* Z = (const bf16_t*)(WS(p) + OFF_Z);
  float* YF = (float*)(WS(p) + (dir ? OFF_YB : OFF_MRG));
  const int tid = otid(), lane = tid & 63, fr = lane & 15, fq = lane >> 4;
  const int wave = __builtin_amdgcn_readfirstlane(tid >> 6);
  const bool lat = b_all >= 16; const int b = lat ? b_all - 16 : b_all;
  const int rowbase = lat ? 4096 + b * 1024 : b * 256, nc = lat ? 8 : 2;
  {
    const float xd = p.ret_decay[(l * 2 + dir) * 4 + h];
    const float lg2 = -log2f(1.f + expf(-xd));
    const float g128 = exp2f(128.f * lg2);
    f32x4 st[4];
    if (lat) {
      const float* s0 = p.state_ret + (size_t)((((b * 2 + l) * 2 + dir) * 4 + h)) * 8192;
#pragma unroll
      for (int bb = 0; bb < 4; ++bb) st[bb] = *(const f32x4*)(s0 + (bb * 16 + fr) * 128 + wave * 16 + fq * 4);
    } else {
#pragma unroll
      for (int bb = 0; bb < 4; ++bb) st[bb] = (f32x4){0.f, 0.f, 0.f, 0.f};
    }
    u32x4 kzr[2], vr4[4];
    auto load_chunk = [&](int cc_) {
      const int rr = rowbase + (dir ? nc - 1 - cc_ : cc_) * 128;
#pragma unroll
      for (int i = 0; i < 2; ++i) { const int idx = tid + NTHR * i, row = idx >> 3, ch = idx & 7; kzr[i] = *(const u32x4*)(Z + (size_t)(rr + row) * 3840 + 2560 + h * 64 + ch * 8); }
#pragma unroll
      for (int i = 0; i < 4; ++i) { const int idx = tid + NTHR * i, row = idx >> 4, ch = idx & 15; vr4[i] = *(const u32x4*)(Z + (size_t)(rr + row) * 3840 + 2816 + h * 128 + ch * 8); }
    };
    load_chunk(0);
#pragma unroll 1
    for (int cc = 0; cc < nc; ++cc) {
      const int c = dir ? nc - 1 - cc : cc;
      const int r0 = rowbase + c * 128;
      __syncthreads();
#pragma unroll
      for (int bb = 0; bb < 4; ++bb) {
        st[bb] *= g128;
        *(u32x2*)(lds + 16384 + vaddr<128>(bb * 16 + fr, (wave * 16 + fq * 4) * 2)) = pack4(st[bb]);
      }
#pragma unroll
      for (int i = 0; i < 2; ++i) {
        const int idx = tid + NTHR * i, row = idx >> 3, ch = idx & 7;
        const u32x4 v = kzr[i];
        const float zeta = exp2f(lg2 * (float)(dir ? row : 127 - row));
        u32x4 w;
        w.x = cvtpk(bflo(v.x) * zeta, bfhi(v.x) * zeta); w.y = cvtpk(bflo(v.y) * zeta, bfhi(v.y) * zeta);
        w.z = cvtpk(bflo(v.z) * zeta, bfhi(v.z) * zeta); w.w = cvtpk(bflo(v.w) * zeta, bfhi(v.w) * zeta);
        *(u32x4*)(lds + row * 128 + ((ch ^ (row & 7)) << 4)) = w;
      }
#pragma unroll
      for (int i = 0; i < 4; ++i) {
        const int idx = tid + NTHR * i, row = idx >> 4, ch = idx & 15;
        *(u32x4*)(lds + 32768 + vaddr<128>(row, ch * 16)) = vr4[i];
      }
      __syncthreads();
      if (cc + 1 < nc) load_chunk(cc + 1);
      {
        const int qw0 = wave * 16;
        const bf16_t* qbase = Z + (size_t)(r0 + qw0 + fr) * 3840 + 2304 + h * 64;
        f32x4 acc[8];
        {
          bf16x8 qx[2];
#pragma unroll
          for (int ks = 0; ks < 2; ++ks) {
            const u32x2 lo = *(const u32x2*)(qbase + ks * 32 + fq * 4);
            const u32x2 hi = *(const u32x2*)(qbase + ks * 32 + 16 + fq * 4);
            u32x4 w; w.x = lo.x; w.y = lo.y; w.z = hi.x; w.w = hi.y;
            qx[ks] = __builtin_bit_cast(bf16x8, w);
          }
#pragma unroll
          for (int c8 = 0; c8 < 8; ++c8) {
            acc[c8] = (f32x4){0.f, 0.f, 0.f, 0.f};
#pragma unroll
            for (int ks = 0; ks < 2; ++ks) {
              const int srow = ks * 32 + fq * 4 + (fr >> 2), sb = (c8 * 16 + (lane & 3) * 4) * 2;
              const bf16x8 sf = cat8(vtr(lds + 16384 + vaddr<128>(srow, sb)), vtr(lds + 16384 + vaddr<128>(srow + 16, sb)));
              acc[c8] = mfma16(sf, qx[ks], acc[c8]);
            }
          }
        }
        bf16x8 qf[2];
#pragma unroll
        for (int ks = 0; ks < 2; ++ks) qf[ks] = *(const bf16x8*)(qbase + ks * 32 + fq * 8);
#pragma unroll
        for (int kk = 0; kk < 4; ++kk) {
          if (dir == 0 ? (kk * 32 > qw0 + 15) : (kk * 32 + 31 < qw0)) continue;
          f32x4 s0 = (f32x4){0.f, 0.f, 0.f, 0.f}, s1 = (f32x4){0.f, 0.f, 0.f, 0.f};
#pragma unroll
          for (int ks = 0; ks < 2; ++ks) {
            const int co = ((ks * 4 + fq) ^ (fr & 7)) << 4;
            const bf16x8 k0f = *(const bf16x8*)(lds + (kk * 32 + fr) * 128 + co);
            const bf16x8 k1f = *(const bf16x8*)(lds + (kk * 32 + 16 + fr) * 128 + co);
            s0 = mfma16(k0f, qf[ks], s0); s1 = mfma16(k1f, qf[ks], s1);
          }
          const int qtok = qw0 + fr, kt0 = kk * 32 + fq * 4;
#pragma unroll
          for (int j = 0; j < 4; ++j) {
            const int ka = kt0 + j, kb = kt0 + 16 + j;
            const bool keepa = dir == 0 ? (ka <= qtok) : (ka >= qtok);
            const bool keepb = dir == 0 ? (kb <= qtok) : (kb >= qtok);
            s0[j] = keepa ? s0[j] : 0.f; s1[j] = keepb ? s1[j] : 0.f;
          }
          u32x4 w; w.x = cvtpk(s0[0], s0[1]); w.y = cvtpk(s0[2], s0[3]); w.z = cvtpk(s1[0], s1[1]); w.w = cvtpk(s1[2], s1[3]);
          const bf16x8 pb = __builtin_bit_cast(bf16x8, w);
#pragma unroll
          for (int c8 = 0; c8 < 8; ++c8) {
            const int vrow = kk * 32 + fq * 4 + (fr >> 2), vb = (c8 * 16 + (lane & 3) * 4) * 2;
            const bf16x8 vf = cat8(vtr(lds + 32768 + vaddr<128>(vrow, vb)), vtr(lds + 32768 + vaddr<128>(vrow + 16, vb)));
            acc[c8] = mfma16(vf, pb, acc[c8]);
          }
        }
        {
          const int qtok = qw0 + fr;
          const float rowfac = exp2f(lg2 * (float)(dir ? -qtok : qtok - 127));
          const int row = r0 + qtok;
          float* yp = YF + (size_t)row * 512 + h * 128 + fq * 4;
#pragma unroll
          for (int c8 = 0; c8 < 8; ++c8) *(f32x4*)(yp + c8 * 16) = acc[c8] * rowfac;
        }
      }
#pragma unroll
      for (int kk = 0; kk < 4; ++kk) {
        const int trow = kk * 32 + fq * 4 + (fr >> 2);
        bf16x8 kz[4];
#pragma unroll
        for (int bb = 0; bb < 4; ++bb) {
          const int col = bb * 16 + (lane & 3) * 4;
          const s16x4 lo = vtr(lds + trow * 128 + (((col >> 3) ^ (trow & 7)) << 4) + (col & 7) * 2);
          const s16x4 hi = vtr(lds + (trow + 16) * 128 + (((col >> 3) ^ (trow & 7)) << 4) + (col & 7) * 2);
          kz[bb] = cat8(lo, hi);
        }
        const int vb = (wave * 16 + (lane & 3) * 4) * 2;
        const bf16x8 vt = cat8(vtr(lds + 32768 + vaddr<128>(trow, vb)), vtr(lds + 32768 + vaddr<128>(trow + 16, vb)));
#pragma unroll
        for (int bb = 0; bb < 4; ++bb) st[bb] = mfma16(vt, kz[bb], st[bb]);
      }
    }
    if (!lat) {
      float* dst = OUTP(p) + OUT_ST + (size_t)((((b * 2 + l) * 2 + dir) * 4 + h)) * 8192;
#pragma unroll
      for (int bb = 0; bb < 4; ++bb) *(f32x4*)(dst + (bb * 16 + fr) * 128 + wave * 16 + fq * 4) = st[bb];
    }
  }
  asm volatile("s_waitcnt vmcnt(0)" ::: "memory");
  __syncthreads();
  if (tid == 0) {
    __builtin_amdgcn_fence(__ATOMIC_RELEASE, "agent");
    asm volatile("s_waitcnt vmcnt(0)" ::: "memory");
    (void)__hip_atomic_fetch_add((unsigned*)(WS(p) + OFF_CNT) + 64 + (l * 20 + b_all) * 4 + h, 1u, __ATOMIC_RELAXED, __HIP_MEMORY_SCOPE_AGENT);
  }
}
__device__ void unitCF(const Params& p, int wb, int l, char* lds, int b_all, int h, int tb) {
  const int tid = otid(), lane = tid & 63, wid = tid >> 6;
  if (tid == 0) {
    unsigned* dn = (unsigned*)(WS(p) + OFF_CNT) + 64 + (l * 20 + b_all) * 4 + h;
    unsigned sp = 0;
    while (__hip_atomic_load(dn, __ATOMIC_RELAXED, __HIP_MEMORY_SCOPE_AGENT) < 2u) { __builtin_amdgcn_s_sleep(2); if (++sp > (1u << 22)) break; }
    __builtin_amdgcn_fence(__ATOMIC_ACQUIRE, "agent");
    asm volatile("s_waitcnt vmcnt(0)" ::: "memory");
  }
  __syncthreads();
  const bf16_t* Z = (const bf16_t*)(WS(p) + OFF_Z);
  const float* YF = (const float*)(WS(p) + OFF_MRG);
  const float* YB = (const float*)(WS(p) + OFF_YB);
  bf16_t* OC = (bf16_t*)(WS(p) + OFF_OC);
  const bool lat = b_all >= 16; const int b = lat ? b_all - 16 : b_all;
  const int row0 = (lat ? 4096 + b * 1024 : b * 256) + tb * 256 + wid * 32;
  const int sub = lane >> 4, l16 = lane & 15;
  const f32x4 g0 = *(const f32x4*)(p.ret_norm_g + l * 128 + l16 * 8), g1 = *(const f32x4*)(p.ret_norm_g + l * 128 + l16 * 8 + 4);
#pragma unroll 2
  for (int i = 0; i < 8; ++i) {
    const int row = row0 + i * 4 + sub;
    const size_t ro = (size_t)row * 512 + h * 128 + l16 * 8;
    f32x4 a0 = *(const f32x4*)(YF + ro) + *(const f32x4*)(YB + ro), a1 = *(const f32x4*)(YF + ro + 4) + *(const f32x4*)(YB + ro + 4);
    const u32x4 cgw = *(const u32x4*)(Z + (size_t)row * 3840 + 3328 + h * 128 + l16 * 8);
    float s = ((a0[0] + a0[1]) + (a0[2] + a0[3])) + ((a1[0] + a1[1]) + (a1[2] + a1[3]));
    s += __shfl_xor(s, 8); s += __shfl_xor(s, 4); s += __shfl_xor(s, 2); s += __shfl_xor(s, 1);
    const float mu = s * (1.f / 128.f);
    a0 = a0 - mu; a1 = a1 - mu;
    float q = ((a0[0] * a0[0] + a0[1] * a0[1]) + (a0[2] * a0[2] + a0[3] * a0[3])) + ((a1[0] * a1[0] + a1[1] * a1[1]) + (a1[2] * a1[2] + a1[3] * a1[3]));
    q += __shfl_xor(q, 8); q += __shfl_xor(q, 4); q += __shfl_xor(q, 2); q += __shfl_xor(q, 1);
    const float rstd = rsqrtf(q * (1.f / 128.f) + LN_EPS);
    f32x4 c0 = unpack4((u32x2){cgw.x, cgw.y}), c1 = unpack4((u32x2){cgw.z, cgw.w});
#pragma unroll
    for (int j = 0; j < 4; ++j) { c0[j] = c0[j] * __builtin_amdgcn_rcpf(1.f + __expf(-c0[j])); c1[j] = c1[j] * __builtin_amdgcn_rcpf(1.f + __expf(-c1[j])); }
    const u32x2 o0 = pack4(a0 * rstd * g0 * c0), o1 = pack4(a1 * rstd * g1 * c1);
    *(u32x4*)(OC + ro) = (u32x4){o0.x, o0.y, o1.x, o1.y};
  }
}


#define PG8_FLAGS true, true
__device__ void phase_att(const Params& p, int wb, int l, char* lds, LAS unsigned char* ldsg) {
  unsigned* cnt = (unsigned*)(WS(p) + OFF_CNT) + l;
  for (;;) {
    __syncthreads();
    if (otid() == 0) *(int*)(lds + LDS_FLAG) = (int)atomicAdd(cnt, 1u);
    __syncthreads();
    const int u = __builtin_amdgcn_readfirstlane(*(const int*)(lds + LDS_FLAG));
    if (u >= 1152) break;
    if (u < 32) unitC(p, wb, l, lds, 16 + (u >> 3), (u >> 1) & 3, u & 1);
    else if (u < 160) { const int v = u - 32; unitA(p, wb, l, lds, 16 + (v >> 5), (v >> 3) & 3, v & 7); }
    else if (u < 256) {
      pg8::Gemm g{(const bf16_t*)(WS(p) + OFF_H), (const bf16_t*)(WS(p) + OFF_WCAT + l * SZ_WCAT), 1024, 1024};
      SchedG1 SG; SG.sz.init(8192, 3840, (int)gridDim.x, 0, 16); SG.sg.init(8192, 3072, (int)gridDim.x, 0, 16);
      SchedOne S1; SG.at(768 + (u - 160), S1.u0);
      EpiSplit<EpiG1, false, 1> E{EpiG1{p.ws, p.b_gate, p.out, l}, p.ws, OFF_OA, 256 + l * 1024, ldsg, wb};
      pg8::gemm_phase<EpiSplit<EpiG1, false, 1>, SchedOne, PG8_FLAGS>(ldsg, g, S1, E, wb);
    }
    else if (u < 384) { const int v = u - 256; unitC(p, wb, l, lds, v >> 3, (v >> 1) & 3, v & 1); }
    else if (u < 512) { const int v = u - 384; unitA(p, wb, l, lds, v >> 3, (v >> 1) & 3, v & 1); }
    else if (u < 768) { const int v = u - 512; unitB(p, wb, l, lds, 16 + (v >> 6), (v >> 5) & 1, v & 31); }
    else if (u < 832) { const int v = u - 768; unitCF(p, wb, l, lds, 16 + (v >> 4), (v >> 2) & 3, v & 3); }
    else if (u < 896) { const int v = u - 832; unitCF(p, wb, l, lds, v >> 2, v & 3, 0); }
    else { const int v = u - 896; unitB(p, wb, l, lds, v >> 4, (v >> 3) & 1, v & 7); }
  }
}

template <bool COMBINE, int NR>
__device__ void ln_rows(const Params& p, int wb, int row_lo, int row_hi, const float* Y, const float* P1, const float* gate, const float* g, const float* bta, const float* md, int sh_off, int sc_off) {
  float* X = OUTP(p) + OUT_X;
  bf16_t* H = (bf16_t*)(WS(p) + OFF_H);
  const int tid = otid(), lane = tid & 63, wid = tid >> 6;
  for (int row0 = row_lo + wid * NR; row0 < row_hi; row0 += 8 * NR) {
    f32x4 v[NR][4];
    if (!COMBINE) {
#pragma unroll
      for (int r = 0; r < NR; ++r)
#pragma unroll
        for (int k = 0; k < 2; ++k) {
          const u32x4 w = *(const u32x4*)((const bf16_t*)Y + (size_t)(row0 + r) * 1024 + k * 512 + lane * 8);
          v[r][2 * k] = unpack4((u32x2){w.x, w.y}); v[r][2 * k + 1] = unpack4((u32x2){w.z, w.w});
        }
    } else {
      const bf16_t* Yb = (const bf16_t*)Y; const bf16_t* Pb = (const bf16_t*)P1;
#pragma unroll
      for (int r = 0; r < NR; ++r)
#pragma unroll
        for (int k = 0; k < 2; ++k) {
          const int cb = k * 512 + lane * 8;
          const u32x4 w0 = *(const u32x4*)(Yb + (size_t)(row0 + r) * 1024 + cb), w1 = *(const u32x4*)(Pb + (size_t)(row0 + r) * 1024 + cb);
          const f32x4 fa = unpack4((u32x2){w0.x, w0.y}) + unpack4((u32x2){w1.x, w1.y}), fb = unpack4((u32x2){w0.z, w0.w}) + unpack4((u32x2){w1.z, w1.w});
          const float* xr = X + (size_t)(row0 + r) * 1024 + cb; const float* gr = gate + row_group(row0 + r) * 6144 + cb;
          v[r][2 * k] = *(const f32x4*)xr * ALPHA_RES + *(const f32x4*)gr * fa;
          v[r][2 * k + 1] = *(const f32x4*)(xr + 4) * ALPHA_RES + *(const f32x4*)(gr + 4) * fb;
        }
    }
#pragma unroll
    for (int r = 0; r < NR; ++r) {
      const int row = row0 + r;
      float s = 0.f;
#pragma unroll
      for (int i = 0; i < 4; ++i) s += (v[r][i][0] + v[r][i][1]) + (v[r][i][2] + v[r][i][3]);
      const float mu = wave_sum(s) * (1.f / 1024.f);
      float q = 0.f;
#pragma unroll
      for (int i = 0; i < 4; ++i) { v[r][i] = v[r][i] - mu; q += (v[r][i][0] * v[r][i][0] + v[r][i][1] * v[r][i][1]) + (v[r][i][2] * v[r][i][2] + v[r][i][3] * v[r][i][3]); }
      const float rstd = rsqrtf(wave_sum(q) * (1.f / 1024.f) + LN_EPS);
      const float* mrow = md ? md + row_group(row) * 6144 : nullptr;
#pragma unroll
      for (int k = 0; k < 2; ++k) {
        const int cb = k * 512 + lane * 8;
        const f32x4 x0 = v[r][2 * k] * rstd * *(const f32x4*)(g + cb) + *(const f32x4*)(bta + cb);
        const f32x4 x1 = v[r][2 * k + 1] * rstd * *(const f32x4*)(g + cb + 4) + *(const f32x4*)(bta + cb + 4);
        *(f32x4*)(X + (size_t)row * 1024 + cb) = x0; *(f32x4*)(X + (size_t)row * 1024 + cb + 4) = x1;
        if (mrow) {
          const f32x4 h0 = x0 * (*(const f32x4*)(mrow + sc_off + cb) + 1.f) + *(const f32x4*)(mrow + sh_off + cb);
          const f32x4 h1 = x1 * (*(const f32x4*)(mrow + sc_off + cb + 4) + 1.f) + *(const f32x4*)(mrow + sh_off + cb + 4);
          const u32x2 a0 = pack4(h0), a1 = pack4(h1);
          *(u32x4*)(H + (size_t)row * 1024 + cb) = (u32x4){a0.x, a0.y, a1.x, a1.y};
        }
      }
    }
  }
}
template <bool COMBINE, int NR>
__device__ void phase_ln(const Params& p, int wb, const float* Y, const float* P1, const float* gate, const float* g, const float* bta, const float* md, int sh_off, int sc_off) {
  const int rpb = 8192 / (int)gridDim.x;
  ln_rows<COMBINE, NR>(p, wb, (int)blockIdx.x * rpb, ((int)blockIdx.x + 1) * rpb, Y, P1, gate, g, bta, md, sh_off, sc_off);
}

#define XB_TMO      128
#define XB_XCNT(j)  (256  + 64 * (j))
#define XB_XSUB(j)  (1280 + 64 * (j))
#define XB_XGEN(j)  (2304 + 64 * (j))
#define XB_TOP      3328
#define XB_TOPGEN   3392
#define XCD_BAR_WORDS 3456
#define XB_SPIN_CAP (1u << 18)
__device__ __forceinline__ unsigned xb_ld(unsigned* p)              { return __hip_atomic_load(p, __ATOMIC_RELAXED, __HIP_MEMORY_SCOPE_AGENT); }
__device__ __forceinline__ unsigned xb_add(unsigned* p, unsigned v) { return __hip_atomic_fetch_add(p, v, __ATOMIC_RELAXED, __HIP_MEMORY_SCOPE_AGENT); }
__device__ __forceinline__ unsigned xb_xcc_id() { return (unsigned)__builtin_amdgcn_s_getreg((3 << 11) | 20) & 0xFu; }
#define XB_SPIN(cond, bar) do { unsigned _sp = 0; while (cond) { __builtin_amdgcn_s_sleep(1); \
    if ((++_sp & 255u) == 0u) { if (xb_ld(&(bar)[XB_TMO])) break; if (_sp > XB_SPIN_CAP) { atomicAdd(&(bar)[XB_TMO], 1u); break; } } } } while (0)
__device__ __forceinline__ void xcd_barrier_post(unsigned* bar, bool t0) { if (t0) (void)xb_add(&bar[XB_XCNT(xb_xcc_id())], 1u); }
__device__ __forceinline__ void xcd_barrier_complete(unsigned* bar, unsigned x, unsigned& nloc, unsigned& nx) {
    const unsigned G = gridDim.x * gridDim.y * gridDim.z;
    unsigned sum, cnt, mine, sp = 0u;
    for (;;) {
        sum = 0u; cnt = 0u; mine = 0u;
#pragma unroll
        for (unsigned j = 0; j < 16; ++j) { const unsigned c = xb_ld(&bar[XB_XCNT(j)]); sum += c; cnt += (c > 0u) ? 1u : 0u; mine = (j == x) ? c : mine; }
        if (sum == G) break;
        __builtin_amdgcn_s_sleep(1);
        if ((++sp & 255u) == 0u) { if (xb_ld(&bar[XB_TMO])) break; if (sp > XB_SPIN_CAP) { atomicAdd(&bar[XB_TMO], 1u); break; } }
    }
    nloc = mine > 0u ? mine : 1u; nx = cnt > 0u ? cnt : 1u;
}
__device__ __forceinline__ void xcd_barrier(unsigned* bar, volatile LAS unsigned* st, bool t0) {
    asm volatile("s_waitcnt vmcnt(0)" ::: "memory");
    __syncthreads();
    if (t0) {
        const unsigned x = xb_xcc_id();
        __builtin_amdgcn_s_waitcnt(0);
        unsigned nloc = st[0], nx = st[1];
        if (nloc == 0u) { xcd_barrier_complete(bar, x, nloc, nx); st[0] = nloc; st[1] = nx; }
        const unsigned old = xb_add(&bar[XB_XSUB(x)], 1u);
        const unsigned gen = old / nloc;
        if (old + 1u == (gen + 1u) * nloc) {
            __builtin_amdgcn_fence(__ATOMIC_RELEASE, "agent");
            asm volatile("s_waitcnt vmcnt(0)" ::: "memory");
            const unsigned og = xb_add(&bar[XB_TOP], 1u);
            const unsigned tg = og / nx;
            if (og + 1u == (tg + 1u) * nx) xb_add(&bar[XB_TOPGEN], 1u);
            else XB_SPIN(xb_ld(&bar[XB_TOPGEN]) == tg, bar);
            __builtin_amdgcn_fence(__ATOMIC_ACQUIRE, "agent");
            xb_add(&bar[XB_XGEN(x)], 1u);
            asm volatile("s_waitcnt vmcnt(0)" ::: "memory");
        } else {
            XB_SPIN(xb_ld(&bar[XB_XGEN(x)]) == gen, bar);
            __builtin_amdgcn_fence(__ATOMIC_ACQUIRE, "agent");
            asm volatile("s_waitcnt vmcnt(0)" ::: "memory");
        }
    }
    __syncthreads();
}
#define GRID_BAR() xcd_barrier((unsigned*)(WS(p) + OFF_BAR), (volatile LAS unsigned*)(ldsg + LDS_ST), otid() == 0)

__global__ void __launch_bounds__(NTHR, 2) fwd_megakernel(Params p) {
  const int wb = __builtin_amdgcn_readfirstlane((int)threadIdx.x) & ~63;
  cg::grid_group grid = cg::this_grid();
  extern __shared__ __attribute__((aligned(16))) unsigned char lds_dyn[];
  char* lds = (char*)lds_dyn;
  LAS unsigned char* ldsg = (LAS unsigned char*)lds_dyn;
  if (p.ws == nullptr) grid.sync();
  { const int t_ = otid(); if (t_ < 4) ((LAS unsigned*)(ldsg + LDS_ST))[t_] = 0u; __syncthreads(); xcd_barrier_post((unsigned*)(WS(p) + OFF_BAR), t_ == 0); }
  phase0(p, wb, lds);
  GRID_BAR();
  phase_h0(p, wb);
  GRID_BAR();
#pragma unroll 1
  for (int l = 0; l < 2; ++l) {
    {
      pg8::Gemm g{(const bf16_t*)(WS(p) + OFF_H), (const bf16_t*)(WS(p) + OFF_WCAT + l * SZ_WCAT), 1024, 1024};
      SchedG1 S; S.sz.init(8192, 3840, (int)gridDim.x, (int)blockIdx.x, 16); S.sg.init(8192, 3072, (int)gridDim.x, (int)blockIdx.x, 16);
      EpiSplit<EpiG1, false, 1> E{EpiG1{p.ws, p.b_gate, p.out, l}, p.ws, OFF_OA, 256 + l * 1024, ldsg, wb};
      pg8::gemm_phase<EpiSplit<EpiG1, false, 1>, SchedG1, PG8_FLAGS>(ldsg, g, S, E, wb);
    }
    GRID_BAR();
    phase_att(p, wb, l, lds, ldsg);
    GRID_BAR();
    {
      pg8::Gemm g{(const bf16_t*)(WS(p) + OFF_OA), (const bf16_t*)(WS(p) + OFF_WP + l * SZ_WP), 512, 512};
      SchedBr S; S.so.init(8192, 1024, (int)gridDim.x, (int)blockIdx.x, 8);
      EpiSplit<EpiG2, true, 2> E{EpiG2{p.ws}, p.ws, OFF_Z, 256 + l * 1024 + 256, ldsg, wb};
      pg8::gemm_phase<EpiSplit<EpiG2, true, 2>, SchedBr, PG8_FLAGS>(ldsg, g, S, E, wb);
      if (l == 0 && blockIdx.x >= 128) { const int i0 = ((int)blockIdx.x - 128) * 5; deferred_convert(p, wb, i0, i0 + 5, lds); }
    }
    GRID_BAR();
    {
      pg8::Gemm g{(const bf16_t*)(WS(p) + OFF_MRG), (const bf16_t*)(WS(p) + OFF_WO + l * SZ_WO), 1024, 1024};
      pg8::StaticOrder S; S.init(8192, 1024, (int)gridDim.x, (int)blockIdx.x, 16);
      const float* xc = l == 0 ? p.x_prompt : p.out + OUT_X;
      const float* xl = l == 0 ? p.x_sample : p.out + OUT_X + (size_t)4096 * 1024;
      EpiSplit<EpiG3, false, 1> E{EpiG3{p.ws, xc, xl, l, 2048}, p.ws, OFF_Z, 256 + l * 1024 + 512, ldsg, wb};
      pg8::gemm_phase<EpiSplit<EpiG3, false, 1>, pg8::StaticOrder, PG8_FLAGS>(ldsg, g, S, E, wb);
      if (l == 0 && blockIdx.x >= 128) { const int i0 = 640 + ((int)blockIdx.x - 128) * 8; deferred_convert(p, wb, i0, i0 + 8 < NJ_DEF ? i0 + 8 : NJ_DEF, lds); }
    }
    GRID_BAR();
    phase_ln<false, 4>(p, wb, (const float*)(WS(p) + OFF_Y), nullptr, nullptr, p.ln1_g + l * 1024, p.ln1_b + l * 1024, (const float*)(WS(p) + OFF_MOD) + l * 5 * 6144, 3072, 4096);
    GRID_BAR();
    {
      pg8::Gemm g{(const bf16_t*)(WS(p) + OFF_H), (const bf16_t*)(WS(p) + OFF_WF1 + l * SZ_WF), 1024, 1024};
      pg8::StaticOrder S; S.init(8192, 4096, (int)gridDim.x, (int)blockIdx.x, 16);
      EpiG4 E{p.ws, wb};
      pg8::gemm_phase<EpiG4, pg8::StaticOrder, PG8_FLAGS>(ldsg, g, S, E, wb);
    }
    GRID_BAR();
    {
      pg8::Gemm g{(const bf16_t*)(WS(p) + OFF_HID), (const bf16_t*)(WS(p) + OFF_WF2 + l * SZ_WF), 4096, 2048};
      SchedSplit2 S; S.so.init(8192, 1024, (int)gridDim.x, (int)blockIdx.x, 32); S.khalf_len = 2048; S.sn = 1;
      EpiSplit<EpiG5, false, 1> E{EpiG5{p.ws}, p.ws, OFF_Z, 256 + l * 1024 + 768, ldsg, wb};
      pg8::gemm_phase<EpiSplit<EpiG5, false, 1>, SchedSplit2, PG8_FLAGS>(ldsg, g, S, E, wb);
    }
    GRID_BAR();
    phase_ln<true, 4>(p, wb, (const float*)(WS(p) + OFF_Y), (const float*)(WS(p) + OFF_OA), (const float*)(WS(p) + OFF_MOD) + l * 5 * 6144 + 5120, p.ln2_g + l * 1024, p.ln2_b + l * 1024,
                   l == 0 ? (const float*)(WS(p) + OFF_MOD) + 5 * 6144 : nullptr, 0, 1024);
    GRID_BAR();
  }
}

extern "C" void kernel_launch(void* const* d_in, const int* in_sizes, int n_in, void* d_out, int out_size, void* d_ws, size_t ws_size, hipStream_t stream) {
  static int grid_blocks = 0;
  if (!grid_blocks) {
    int dev = 0, cus = 0, per_cu = 0;
    (void)hipGetDevice(&dev);
    (void)hipDeviceGetAttribute(&cus, hipDeviceAttributeMultiprocessorCount, dev);
    if (hipFuncSetAttribute((const void*)fwd_megakernel, hipFuncAttributeMaxDynamicSharedMemorySize, LDS_BYTES) != hipSuccess) fprintf(stderr, "hipFuncSetAttribute failed\n");
    (void)hipOccupancyMaxActiveBlocksPerMultiprocessor(&per_cu, fwd_megakernel, NTHR, LDS_BYTES);
    if (per_cu > 1) per_cu = 1;
    if (per_cu < 1) { fprintf(stderr, "occupancy query says 0 blocks per CU\n"); per_cu = 1; }
    grid_blocks = cus * per_cu;
  }
  if (ws_size < WS_NEED) { fprintf(stderr, "workspace too small: %zu < %zu\n", ws_size, (size_t)WS_NEED); return; }
  Params p{};
  const float** f = (const float**)&p;
  for (int i = 0; i < 29; ++i) f[i] = (const float*)d_in[i];
  p.out = (float*)d_out; p.ws = (char*)d_ws;
  p.lam_init[0] = (float)(0.8 - 0.6 * exp(-0.3 * 0.0));
  p.lam_init[1] = (float)(0.8 - 0.6 * exp(-0.3 * 1.0));
  (void)hipMemsetAsync((char*)d_ws + OFF_CNT, 0, OFF_YB - OFF_CNT, stream);
  void* args[] = {&p};
  hipError_t e = hipLaunchCooperativeKernel((void*)fwd_megakernel, dim3(grid_blocks), dim3(NTHR), args, LDS_BYTES, stream);
  if (e != hipSuccess) fprintf(stderr, "cooperative launch failed: %s (grid %d)\n", hipGetErrorString(e), grid_blocks);
}
```
